# Optimizing an MI355X kernel written in HIP

```python
import math
import jax, jax.numpy as jnp
from jax import lax
import numpy as np

D_MODEL = 1024
BATCH = 2
SEQ = 16384
DEPTH = 2

CONV_CH = D_MODEL // 4
CONV_GROUPS = 4
CONV_WIDTH = 31
RET_VDIM = 64
RET_KDIM = RET_VDIM // 2
RET_HEADS = (3 * D_MODEL // 8) // RET_VDIM
RET_CHUNK = 128
ATT_HDIM = 64
ATT_HEADS = (3 * D_MODEL // 8) // ATT_HDIM
DILATED_BRANCHES = ((128, 1), (512, 4), (2048, 16))
ATT_BLOCK = 128
N_BUCKETS = 32
MAX_DISTANCE = 2048
D_FF = 4 * D_MODEL
EPS = 1e-6
ROPE_BASE = 10000.0
NEG_INF = -1e30

RET_W = RET_HEADS * RET_VDIM
ATT_W = ATT_HEADS * ATT_HDIM
MIX_W = CONV_CH + RET_W + ATT_W
IN_SIZES = (2 * CONV_CH, RET_HEADS * RET_KDIM, RET_HEADS * RET_KDIM, RET_W, RET_W, ATT_W, ATT_W, ATT_W)
IN_W = sum(IN_SIZES)
IN_SPLITS = [sum(IN_SIZES[:i + 1]) for i in range(len(IN_SIZES) - 1)]

kernel_name = "hybrid_conv_retention_dilated_attn"

F32 = jnp.float32


def rms_norm(x, g):
    xf = x.astype(F32)
    return xf * lax.rsqrt(jnp.mean(xf * xf, axis=-1, keepdims=True) + EPS) * g.astype(F32)


def conv_mixer(u, conv_w, conv_b, conv_g):
    B, S, _ = u.shape
    a, gate = jnp.split(u, 2, axis=-1)
    h = a * jax.nn.sigmoid(gate)
    h = lax.conv_general_dilated(
        h, conv_w.astype(F32)[:, None, :], window_strides=(1,),
        padding=[(CONV_WIDTH - 1, 0)],
        dimension_numbers=("NWC", "WIO", "NWC"),
        feature_group_count=CONV_CH) + conv_b.astype(F32)
    hg = h.reshape(B, S, CONV_GROUPS, CONV_CH // CONV_GROUPS)
    hg = hg * lax.rsqrt(jnp.mean(hg * hg, axis=-1, keepdims=True) + EPS)
    h = hg.reshape(B, S, CONV_CH) * conv_g.astype(F32)
    return jax.nn.silu(h)


def rotary(x, pos):
    d = x.shape[-1]
    inv = 1.0 / (ROPE_BASE ** jnp.linspace(0.0, 1.0, d // 2, dtype=F32))
    ang = pos[:, None] * inv[None, :]
    c, s = jnp.cos(ang)[:, None, :], jnp.sin(ang)[:, None, :]
    x1, x2 = x[..., 0::2], x[..., 1::2]
    return jnp.stack([x1 * c - x2 * s, x1 * s + x2 * c], axis=-1).reshape(x.shape)


def retention(q, k, v, g, ret_g):
    B, S, H, dk = q.shape
    dv = v.shape[-1]
    C = RET_CHUNK
    N = S // C
    pos = jnp.arange(S, dtype=F32)
    q = rotary(q, pos)
    k = rotary(k, pos) * (dk ** -0.5)
    to_chunks = lambda t: t.reshape(B, N, C, H, t.shape[-1]).transpose(0, 3, 1, 2, 4)
    qc, kc, vc = to_chunks(q), to_chunks(k), to_chunks(v)
    log_gamma = jnp.log(1.0 - 2.0 ** (-5.0 - jnp.arange(H, dtype=F32)))
    idx = jnp.arange(C, dtype=F32)
    diff = idx[:, None] - idx[None, :]
    decay = jnp.where(diff >= 0, jnp.exp(log_gamma[:, None, None] * jnp.maximum(diff, 0.0)), 0.0)
    scores = jnp.einsum("bhnid,bhnjd->bhnij", qc, kc) * decay[None, :, None]
    inner = jnp.einsum("bhnij,bhnje->bhnie", scores, vc)
    k_dec = kc * jnp.exp(log_gamma[:, None] * (C - 1.0 - idx))[None, :, None, :, None]
    kv = jnp.einsum("bhnjd,bhnje->bhnde", k_dec, vc)
    chunk_decay = jnp.exp(log_gamma * C)[None, :, None, None]

    def step(state, kv_n):
        return state * chunk_decay + kv_n, state

    _, states = lax.scan(step, jnp.zeros((B, H, dk, dv), F32), jnp.moveaxis(kv, 2, 0))
    states = jnp.moveaxis(states, 0, 2)
    q_dec = qc * jnp.exp(log_gamma[:, None] * (idx + 1.0))[None, :, None, :, None]
    cross = jnp.einsum("bhnid,bhnde->bhnie", q_dec, states)
    o = (inner + cross).transpose(0, 2, 3, 1, 4).reshape(B, S, H, dv)
    o = o * lax.rsqrt(jnp.mean(o * o, axis=-1, keepdims=True) + EPS)
    o = o.reshape(B, S, H * dv) * ret_g.astype(F32)
    return o * jax.nn.silu(g)


def t5_bucket(dist):
    max_exact = N_BUCKETS // 2
    nf = jnp.maximum(dist, 1).astype(F32)
    large = max_exact + (jnp.log(nf / max_exact) / math.log(MAX_DISTANCE / max_exact)
                         * (N_BUCKETS - max_exact)).astype(jnp.int32)
    large = jnp.minimum(large, N_BUCKETS - 1)
    return jnp.where(dist < max_exact, dist, large)


def dilated_branch(q, k, v, rel_bias, dilation):
    B, H, S, hd = q.shape
    Lb = ATT_BLOCK
    span = Lb * dilation
    S_pad = -(-S // span) * span
    L = S_pad // dilation
    nb = L // Lb

    def gather(t):
        t = jnp.pad(t, ((0, 0), (0, 0), (0, S_pad - S), (0, 0)))
        return t.reshape(B, H, L, dilation, hd).transpose(0, 1, 3, 2, 4).reshape(B, H, dilation, nb, Lb, hd)

    def with_prev(t):
        prev = jnp.concatenate([jnp.zeros_like(t[:, :, :, :1]), t[:, :, :, :-1]], axis=3)
        return jnp.concatenate([prev, t], axis=4)

    qg = gather(q)
    kk, vv = with_prev(gather(k)), with_prev(gather(v))
    qi = jnp.arange(Lb, dtype=jnp.int32)[:, None]
    kj = jnp.arange(2 * Lb, dtype=jnp.int32)[None, :]
    dist = Lb + qi - kj
    band = (dist >= 0) & (dist <= Lb)
    valid = band[None] & ((jnp.arange(nb)[:, None, None] > 0) | (kj[None] >= Lb))
    bias = rel_bias.astype(F32)[t5_bucket(jnp.clip(dist, 0, Lb) * dilation)]
    bias = bias.transpose(2, 0, 1)[None, :, None, None]
    logits = jnp.einsum("bhgnqd,bhgnkd->bhgnqk", qg, kk) * (hd ** -0.5) + bias
    logits = jnp.where(valid, logits, NEG_INF)
    m = jnp.max(logits, axis=-1, keepdims=True)
    p = jnp.exp(logits - m)
    s = jnp.sum(p, axis=-1, keepdims=True)
    o = jnp.einsum("bhgnqk,bhgnkd->bhgnqd", p, vv) / s
    lse = (m + jnp.log(s))[..., 0]
    o = o.reshape(B, H, dilation, L, hd).transpose(0, 1, 3, 2, 4).reshape(B, H, S_pad, hd)[:, :, :S]
    lse = lse.reshape(B, H, dilation, L).transpose(0, 1, 3, 2).reshape(B, H, S_pad)[:, :, :S]
    return o, lse


def dilated_attention(q, k, v, q_g, k_g, rel_bias):
    B, S, H, hd = q.shape
    q = rms_norm(q, q_g).transpose(0, 2, 1, 3)
    k = rms_norm(k, k_g).transpose(0, 2, 1, 3)
    v = v.transpose(0, 2, 1, 3)
    outs, lses = [], []
    for _, dilation in DILATED_BRANCHES:
        o, lse = dilated_branch(q, k, v, rel_bias, dilation)
        outs.append(o)
        lses.append(lse)
    w = jax.nn.softmax(jnp.stack(lses, axis=0), axis=0)
    o = jnp.sum(w[..., None] * jnp.stack(outs, axis=0), axis=0)
    return o.transpose(0, 2, 1, 3).reshape(B, S, H * hd)


def hybrid_layer(x, norm1_g, w_in, conv_w, conv_b, conv_g, ret_g, q_g, k_g,
                 w_out, norm2_g, w_ff1, w_ff2, rel_bias):
    B, S, _ = x.shape
    h = rms_norm(x, norm1_g)
    u = h @ w_in.astype(F32)
    u_conv, rq, rk, rv, rg, aq, ak, av = jnp.split(u, IN_SPLITS, axis=-1)
    conv_out = conv_mixer(u_conv, conv_w, conv_b, conv_g)
    ret_out = retention(rq.reshape(B, S, RET_HEADS, RET_KDIM), rk.reshape(B, S, RET_HEADS, RET_KDIM),
                        rv.reshape(B, S, RET_HEADS, RET_VDIM), rg, ret_g)
    att_out = dilated_attention(aq.reshape(B, S, ATT_HEADS, ATT_HDIM), ak.reshape(B, S, ATT_HEADS, ATT_HDIM),
                                av.reshape(B, S, ATT_HEADS, ATT_HDIM), q_g, k_g, rel_bias)
    mix = jnp.concatenate([conv_out, ret_out, att_out], axis=-1) @ w_out.astype(F32)
    x = x + mix.astype(x.dtype)
    h2 = rms_norm(x, norm2_g)
    ff = jnp.square(jax.nn.relu(h2 @ w_ff1.astype(F32))) @ w_ff2.astype(F32)
    return x + ff.astype(x.dtype)


def setup_inputs(seed: int = 0) -> dict:
    key = jax.random.key(seed)
    ks = jax.random.split(key, 15)
    nrm = lambda k, shape: jax.random.normal(k, shape, F32)
    return {
        "x": nrm(ks[0], (BATCH, SEQ, D_MODEL)),
        "norm1_g": 1.0 + 0.02 * nrm(ks[1], (DEPTH, D_MODEL)),
        "w_in": nrm(ks[2], (DEPTH, D_MODEL, IN_W)) * D_MODEL ** -0.5,
        "conv_w": nrm(ks[3], (DEPTH, CONV_WIDTH, CONV_CH)) * CONV_WIDTH ** -0.5,
        "conv_b": 0.02 * nrm(ks[4], (DEPTH, CONV_CH)),
        "conv_g": 1.0 + 0.02 * nrm(ks[5], (DEPTH, CONV_CH)),
        "ret_g": 1.0 + 0.02 * nrm(ks[6], (DEPTH, RET_W)),
        "q_g": 1.0 + 0.02 * nrm(ks[7], (DEPTH, ATT_HDIM)),
        "k_g": 1.0 + 0.02 * nrm(ks[8], (DEPTH, ATT_HDIM)),
        "w_out": nrm(ks[9], (DEPTH, MIX_W, D_MODEL)) * MIX_W ** -0.5,
        "norm2_g": 1.0 + 0.02 * nrm(ks[10], (DEPTH, D_MODEL)),
        "w_ff1": nrm(ks[11], (DEPTH, D_MODEL, D_FF)) * D_MODEL ** -0.5,
        "w_ff2": nrm(ks[12], (DEPTH, D_FF, D_MODEL)) * D_FF ** -0.5,
        "rel_bias": 0.1 * nrm(ks[13], (N_BUCKETS, ATT_HEADS)),
    }


def reference(x, norm1_g, w_in, conv_w, conv_b, conv_g, ret_g, q_g, k_g,
              w_out, norm2_g, w_ff1, w_ff2, rel_bias):
    for l in range(DEPTH):
        x = hybrid_layer(x, norm1_g[l], w_in[l], conv_w[l], conv_b[l], conv_g[l], ret_g[l],
                         q_g[l], k_g[l], w_out[l], norm2_g[l], w_ff1[l], w_ff2[l], rel_bias)
    return x
```

```cpp
#include <hip/hip_runtime.h>
#include <hip/hip_cooperative_groups.h>
#include <cstdio>
#include <cstdint>
namespace pg8 {
#define PG8_LAS __attribute__((address_space(3)))
typedef unsigned short bf16_t;
typedef short bf16x8 __attribute__((ext_vector_type(8)));
typedef float f32x4 __attribute__((ext_vector_type(4)));
typedef unsigned u32x4 __attribute__((ext_vector_type(4)));
constexpr int BM = 256, BK = 64, HALF = 128, HTB = HALF * BK * 2  , STAGE_BYTES = 8 * HTB, NXCD = 8, WGM = 8;

__host__ __device__ __forceinline__ int lds_byte(int r, int c) { const int st = (r >> 4) * 2 + (c >> 5), rr = r & 15, cc = c & 31, ob = rr * 64 + cc * 2; return st * 1024 + (ob ^ (((ob >> 9) & 1) << 5)); }
__host__ __device__ __forceinline__ void stage_rc(int b, int& R, int& C) { const int st = b / 1024, sb = b % 1024, swz = sb ^ (((sb >> 9) & 1) << 5); R = (st >> 1) * 16 + swz / 64; C = (st & 1) * 32 + (swz % 64) / 2; }
__host__ __device__ __forceinline__ int perm32(int rho) { const int n = rho >> 4, i = rho & 15; return 8 * (i >> 2) + 4 * n + (i & 3); }

struct Unit { int pm, pn; };
struct Gemm { const bf16_t* A; const bf16_t* Bt; int M, N, K; };

struct StaticOrder {
    int nM, nN, nwg, G, c;
    __host__ __device__ void init(int M, int N, int G_, int c_) { nM = M / BM; nN = N / BM; nwg = nM * nN; G = G_; c = c_; }
    __host__ __device__ bool next(int i, Unit& u) const {
        const long L = (long)i * G + c; if (L >= nwg) return false;
        int wgid = (int)L; { const int q = nwg / NXCD, r = nwg % NXCD, xcd = wgid % NXCD, off = wgid / NXCD; wgid = (xcd < r ? xcd * (q + 1) : r * (q + 1) + (xcd - r) * q) + off; }
        const int nig = WGM * nN, gid = wgid / nig, fm = gid * WGM, gsz = (nM - fm) < WGM ? (nM - fm) : WGM;
        u.pm = fm + ((wgid % nig) % gsz); u.pn = (wgid % nig) / gsz; return true;
    }
    __device__ __forceinline__ void a_ready(const Unit&) const {}
    __device__ __forceinline__ void done(const Unit&) const {}
};

__device__ __forceinline__ unsigned cvt_pk_bf16(float lo, float hi) { unsigned r; asm volatile("v_cvt_pk_bf16_f32 %0, %1, %2" : "=v"(r) : "v"(lo), "v"(hi)); return r; }
typedef float f32x2 __attribute__((ext_vector_type(2)));
template <class Epi, class Sched, bool ALIGN_EPI = false, bool SP2 = false>
__device__ __forceinline__ void gemm_phase(PG8_LAS unsigned char* lds, const Gemm g, const Sched& S, const Epi& E) {
    const int tid = threadIdx.x, wid = __builtin_amdgcn_readfirstlane(tid >> 6), lane = tid & 63, wr = wid >> 2, wc = wid & 3, fr = lane & 15, fq = lane >> 4;
    const int K = g.K, nt = K / BK;
    unsigned voffA[2], voffB[2];
#pragma unroll
    for (int i = 0; i < 2; ++i) { int R, C; stage_rc(tid * 16 + i * 8192, R, C); const int Rb = Epi::PERM ? ((R & ~31) + perm32(R & 31)) : R;
        voffA[i] = (unsigned)(R * K + C) * 2u; voffB[i] = (unsigned)(Rb * K + C) * 2u; }
    const size_t kstep = (size_t)(BK * 2);
    const size_t hstep = (size_t)HALF * K * 2;
    const size_t tstep = 2 * hstep;
    const unsigned ldsw = (unsigned)wid * 1024u;
    const int aoff = lds_byte(wr * 64 + fr, fq * 8), boff = lds_byte(wc * 32 + fr, fq * 8);
#define PG8_SA(b, h) (((b) * 2 + (h)) * HTB)
#define PG8_SB(b, h) ((4 + (b) * 2 + (h)) * HTB)
#define PG8_STAGE(bufoff, gbase, voff) do { _Pragma("unroll") for (int _i = 0; _i < 2; ++_i) \
        __builtin_amdgcn_global_load_lds((const unsigned*)((const char*)(gbase) + (voff)[_i]), (PG8_LAS unsigned*)(lds + (bufoff) + ldsw + _i * 8192), 16, 0, 0); } while (0)
#define PG8_LDA(dst, b, h) do { _Pragma("unroll") for (int m = 0; m < 4; ++m) _Pragma("unroll") for (int k = 0; k < 2; ++k) dst[m][k] = *(const PG8_LAS bf16x8*)(lds + PG8_SA(b, h) + aoff + m * 2048 + k * 1024); } while (0)
#define PG8_LDB(dst, b, h) do { _Pragma("unroll") for (int n = 0; n < 2; ++n) _Pragma("unroll") for (int k = 0; k < 2; ++k) dst[n][k] = *(const PG8_LAS bf16x8*)(lds + PG8_SB(b, h) + boff + n * 2048 + k * 1024); } while (0)
#define PG8_MMA(ai, bj, At, Bt) do { __builtin_amdgcn_s_setprio(1); _Pragma("unroll") for (int m = 0; m < 4; ++m) _Pragma("unroll") for (int n = 0; n < 2; ++n) _Pragma("unroll") for (int k = 0; k < 2; ++k) \
        acc[ai][bj][m][n] = __builtin_amdgcn_mfma_f32_16x16x32_bf16(Bt[n][k], At[m][k], acc[ai][bj][m][n], 0, 0, 0); __builtin_amdgcn_s_setprio(0); } while (0)
#define PG8_WAIT_V(n) asm volatile("s_waitcnt vmcnt(" #n ")" ::: "memory")
#define PG8_WAIT_L(n) asm volatile("s_waitcnt lgkmcnt(" #n ")" ::: "memory")
#define PG8_BAR __builtin_amdgcn_s_barrier()
#define PG8_SCHED __builtin_amdgcn_sched_barrier(0)
    Unit cur, nxt; int ui = 0;
    if (!S.next(0, cur)) return;
    f32x4 acc[2][2][4][2];
#pragma unroll
    for (int a = 0; a < 2; ++a)
#pragma unroll
        for (int b = 0; b < 2; ++b)
#pragma unroll
            for (int m = 0; m < 4; ++m)
#pragma unroll
                for (int n = 0; n < 2; ++n) acc[a][b][m][n] = (f32x4){0.f, 0.f, 0.f, 0.f};
    bf16x8 At[4][2], B0[2][2], B1[2][2];
    const char* cA = (const char*)g.A + (size_t)cur.pm * tstep; const char* cB = (const char*)g.Bt + (size_t)cur.pn * tstep;
    S.a_ready(cur);
    if constexpr (SP2) {
        PG8_STAGE(PG8_SB(0, 0), cB, voffB); PG8_STAGE(PG8_SB(0, 1), cB + hstep, voffB); PG8_STAGE(PG8_SA(0, 0), cA, voffA); PG8_STAGE(PG8_SA(0, 1), cA + hstep, voffA);
        if (wr == 1) PG8_BAR;
        PG8_WAIT_V(2); PG8_BAR;
        PG8_STAGE(PG8_SB(1, 0), cB + kstep, voffB); PG8_STAGE(PG8_SA(1, 0), cA + kstep, voffA); PG8_STAGE(PG8_SB(1, 1), cB + hstep + kstep, voffB);
        PG8_WAIT_V(6); PG8_BAR;
    } else {
        PG8_STAGE(PG8_SB(0, 0), cB, voffB); PG8_STAGE(PG8_SA(0, 0), cA, voffA); PG8_STAGE(PG8_SB(0, 1), cB + hstep, voffB); PG8_STAGE(PG8_SA(0, 1), cA + hstep, voffA);
        if (wr == 1) PG8_BAR;
        PG8_WAIT_V(4); PG8_BAR;
        PG8_STAGE(PG8_SB(1, 0), cB + kstep, voffB); PG8_STAGE(PG8_SA(1, 0), cA + kstep, voffA); PG8_STAGE(PG8_SB(1, 1), cB + hstep + kstep, voffB);
        PG8_WAIT_V(6); PG8_BAR;
    }
    for (;;) {
        const bool has_next = S.next(ui + 1, nxt);
        const char* nA = has_next ? (const char*)g.A + (size_t)nxt.pm * tstep : cA; const char* nB = has_next ? (const char*)g.Bt + (size_t)nxt.pn * tstep : cB;
        for (int t = 0; t < nt; t += 2) {
            const bool last = (t == nt - 2);
            const char* a1 = cA + (size_t)(t + 1) * kstep;
            const char* a2 = last ? nA : cA + (size_t)(t + 2) * kstep; const char* b2 = last ? nB : cB + (size_t)(t + 2) * kstep;
            const char* a3 = a2 + kstep; const char* b3 = b2 + kstep;
            if (last && has_next) S.a_ready(nxt);
            if constexpr (SP2) {
            PG8_LDB(B0, 0, 0); PG8_LDB(B1, 0, 1); PG8_SCHED; PG8_LDA(At, 0, 0); PG8_STAGE(PG8_SA(1, 1), a1 + hstep, voffA);
            PG8_WAIT_V(8); PG8_WAIT_L(0); PG8_BAR; PG8_MMA(0, 0, At, B0); PG8_MMA(0, 1, At, B1); PG8_BAR; PG8_SCHED;
            PG8_LDA(At, 0, 1); PG8_STAGE(PG8_SB(0, 0), b2, voffB); PG8_STAGE(PG8_SB(0, 1), b2 + hstep, voffB); PG8_STAGE(PG8_SA(0, 0), a2, voffA);
            PG8_WAIT_V(8); PG8_WAIT_L(0); PG8_BAR; PG8_MMA(1, 0, At, B0); PG8_MMA(1, 1, At, B1); PG8_BAR; PG8_SCHED;
            PG8_LDB(B0, 1, 0); PG8_LDB(B1, 1, 1); PG8_SCHED; PG8_LDA(At, 1, 0); PG8_STAGE(PG8_SA(0, 1), a2 + hstep, voffA);
            PG8_WAIT_V(8); PG8_WAIT_L(0); PG8_BAR; PG8_MMA(0, 0, At, B0); PG8_MMA(0, 1, At, B1); PG8_BAR; PG8_SCHED;
            PG8_LDA(At, 1, 1); PG8_STAGE(PG8_SB(1, 0), b3, voffB); PG8_STAGE(PG8_SB(1, 1), b3 + hstep, voffB); PG8_STAGE(PG8_SA(1, 0), a3, voffA);
            PG8_WAIT_V(8); PG8_WAIT_L(0); PG8_BAR; PG8_MMA(1, 0, At, B0); PG8_MMA(1, 1, At, B1); PG8_BAR; PG8_SCHED;
            } else {
            PG8_LDB(B0, 0, 0); PG8_SCHED; PG8_LDA(At, 0, 0); PG8_STAGE(PG8_SA(1, 1), a1 + hstep, voffA);
            PG8_WAIT_L(8); PG8_BAR; PG8_WAIT_L(0); PG8_MMA(0, 0, At, B0); PG8_BAR; PG8_SCHED;
            PG8_LDB(B1, 0, 1); PG8_STAGE(PG8_SB(0, 0), b2, voffB);
            PG8_BAR; PG8_WAIT_L(0); PG8_MMA(0, 1, At, B1); PG8_BAR;
            PG8_LDA(At, 0, 1); PG8_STAGE(PG8_SA(0, 0), a2, voffA);
            PG8_BAR; PG8_WAIT_L(0); PG8_MMA(1, 0, At, B0); PG8_BAR; PG8_SCHED;
            PG8_STAGE(PG8_SB(0, 1), b2 + hstep, voffB);
            PG8_WAIT_V(6); PG8_BAR; PG8_MMA(1, 1, At, B1); PG8_BAR;
            PG8_LDB(B0, 1, 0); PG8_SCHED; PG8_LDA(At, 1, 0); PG8_STAGE(PG8_SA(0, 1), a2 + hstep, voffA);
            PG8_WAIT_L(8); PG8_BAR; PG8_WAIT_L(0); PG8_MMA(0, 0, At, B0); PG8_BAR; PG8_SCHED;
            PG8_LDB(B1, 1, 1); PG8_STAGE(PG8_SB(1, 0), b3, voffB);
            PG8_BAR; PG8_WAIT_L(0); PG8_MMA(0, 1, At, B1); PG8_BAR;
            PG8_LDA(At, 1, 1); PG8_STAGE(PG8_SA(1, 0), a3, voffA);
            PG8_BAR; PG8_WAIT_L(0); PG8_MMA(1, 0, At, B0); PG8_BAR; PG8_SCHED;
            PG8_STAGE(PG8_SB(1, 1), b3 + hstep, voffB);
            PG8_WAIT_V(6); PG8_BAR; PG8_MMA(1, 1, At, B1); PG8_BAR;
            }
        }
        if constexpr (ALIGN_EPI) { if (wr == 0) PG8_BAR; }
        if constexpr (!Epi::AFTER_DRAIN) { E(acc, cur, wr, wc, fr, fq); S.done(cur); }
        if (!has_next) break;
#pragma unroll
        for (int a = 0; a < 2; ++a)
#pragma unroll
            for (int b = 0; b < 2; ++b)
#pragma unroll
                for (int m = 0; m < 4; ++m)
#pragma unroll
                    for (int n = 0; n < 2; ++n) acc[a][b][m][n] = (f32x4){0.f, 0.f, 0.f, 0.f};
        cur = nxt; cA = nA; cB = nB; ++ui;
        if constexpr (ALIGN_EPI) { if (wr == 1) PG8_BAR; }
    }
    PG8_WAIT_V(0);
    if constexpr (!ALIGN_EPI) { if (wr == 0) PG8_BAR; }
    PG8_BAR;
    if constexpr (Epi::AFTER_DRAIN) { E.fused(acc, cur, wr, wc, fr, fq, lds, wid, lane); S.done(cur); }
#undef PG8_SA
#undef PG8_SB
#undef PG8_STAGE
#undef PG8_LDA
#undef PG8_LDB
#undef PG8_MMA
#undef PG8_WAIT_V
#undef PG8_WAIT_L
#undef PG8_BAR
#undef PG8_SCHED
}
}
namespace cg = cooperative_groups;
#define GAS __attribute__((address_space(1)))
#define LAS __attribute__((address_space(3)))
typedef unsigned short bf16;
typedef float f32x4 __attribute__((ext_vector_type(4)));
typedef unsigned u32x4 __attribute__((ext_vector_type(4)));
constexpr int NB = 2, S = 16384, D = 1024, M = NB * S, INW = 2816, FF = 4096, DEPTH = 2;
constexpr int C_A = 0, C_G = 256, C_RQ = 512, C_RK = 704, C_RV = 896, C_RG = 1280, C_AQ = 1664, C_AK = 2048, C_AV = 2432;
constexpr int MX_CONV = 0, MX_RET = 256, MX_ATT = 640;
constexpr float EPS = 1e-6f;
constexpr size_t MiB = 1u << 20;
constexpr size_t WS_CTL = 0, CTL_BYTES = 1 * MiB;
constexpr size_t WS_W = 2 * MiB;
constexpr size_t W_LAYER = 24641536, W_IN = 0, W_OUT = 5767168, W_F1 = 7864320, W_F2 = 16252928;
constexpr size_t WS_SSQ = 50 * MiB;
constexpr size_t WS_ROPE = 52 * MiB;
constexpr size_t WS_XB = 64 * MiB;
constexpr size_t WS_H = 128 * MiB;
constexpr size_t WS_U = 128 * MiB;
constexpr size_t WS_MIX = 304 * MiB;
constexpr size_t WS_KV = 384 * MiB;
constexpr size_t WS_ST = 396 * MiB;
constexpr size_t WS_END = 408 * MiB;

struct P { const float* in[14]; float* out; unsigned char* ws; int layer; int pad; };

__device__ __forceinline__ float bf_lo(unsigned w) { return __uint_as_float(w << 16); }
__device__ __forceinline__ float bf_hi(unsigned w) { return __uint_as_float(w & 0xffff0000u); }
__device__ __forceinline__ unsigned f2bf(float f) { unsigned u = __float_as_uint(f); return (u + 0x7fffu + ((u >> 16) & 1u)) >> 16; }
__device__ __forceinline__ unsigned pk2(float lo, float hi) { return f2bf(lo) | (f2bf(hi) << 16); }
__device__ __forceinline__ void unpack8(const u32x4 w, float (&v)[8]) {
    v[0] = bf_lo(w.x); v[1] = bf_hi(w.x); v[2] = bf_lo(w.y); v[3] = bf_hi(w.y); v[4] = bf_lo(w.z); v[5] = bf_hi(w.z); v[6] = bf_lo(w.w); v[7] = bf_hi(w.w); }
__device__ __forceinline__ u32x4 pack8(const float (&v)[8]) { u32x4 w; w.x = pk2(v[0], v[1]); w.y = pk2(v[2], v[3]); w.z = pk2(v[4], v[5]); w.w = pk2(v[6], v[7]); return w; }
__device__ __forceinline__ float wave_sum(float v) {
#pragma unroll
    for (int o = 1; o < 64; o <<= 1) v += __shfl_xor(v, o);
    return v; }
__device__ __forceinline__ float gamma_log2(int h) { return log2f(1.0f - exp2f(-5.0f - (float)h)); }

__device__ __forceinline__ float row_rstd(const float* ssq, int row) {
    const f32x4* q = (const f32x4*)(ssq + (size_t)row * 16); const f32x4 a = q[0], b = q[1], c = q[2], d = q[3];
    const float s = ((a.x + a.y) + (a.z + a.w)) + ((b.x + b.y) + (b.z + b.w)) + ((c.x + c.y) + (c.z + c.w)) + ((d.x + d.y) + (d.z + d.w));
    return 1.0f / sqrtf(s * (1.0f / 1024.0f) + EPS); }

template <int ACT  > struct EpiNormBf16 {
    static constexpr bool PERM = true, AFTER_DRAIN = false;
    bf16* O; const float* ssq; int ldc; int pad;
    __device__ __forceinline__ void operator()(const pg8::f32x4 (&acc)[2][2][4][2], const pg8::Unit& u, int wr, int wc, int fr, int fq) const {
        const int row0 = u.pm * 256 + wr * 64 + fr, col0 = u.pn * 256 + wc * 32 + 8 * fq;
#pragma unroll
        for (int ai = 0; ai < 2; ++ai)
#pragma unroll
            for (int m = 0; m < 4; ++m) { const int row = row0 + ai * 128 + m * 16; const float rs = row_rstd(ssq, row); bf16* rowp = O + (size_t)row * ldc + col0;
#pragma unroll
                for (int bj = 0; bj < 2; ++bj) { pg8::f32x4 v0 = acc[ai][bj][m][0] * rs, v1 = acc[ai][bj][m][1] * rs;
                    if (ACT == 1) {
#pragma unroll
                        for (int t = 0; t < 4; ++t) { float a = fmaxf(v0[t], 0.f), b = fmaxf(v1[t], 0.f); v0[t] = a * a; v1[t] = b * b; } }
                    u32x4 w; w.x = pg8::cvt_pk_bf16(v0[0], v0[1]); w.y = pg8::cvt_pk_bf16(v0[2], v0[3]); w.z = pg8::cvt_pk_bf16(v1[0], v1[1]); w.w = pg8::cvt_pk_bf16(v1[2], v1[3]);
                    *(u32x4*)(rowp + bj * 128) = w; } }
    }
};
struct EpiRes {
    static constexpr bool PERM = true, AFTER_DRAIN = false;
    const float* xi; float* xo; bf16* xb; float* ssq;
    __device__ __forceinline__ void operator()(const pg8::f32x4 (&acc)[2][2][4][2], const pg8::Unit& u, int wr, int wc, int fr, int fq) const {
        const int row0 = u.pm * 256 + wr * 64 + fr, col0 = u.pn * 256 + wc * 32 + 8 * fq;
#pragma unroll
        for (int ai = 0; ai < 2; ++ai)
#pragma unroll
            for (int m = 0; m < 4; ++m) { const int row = row0 + ai * 128 + m * 16; float q = 0.f;
#pragma unroll
                for (int bj = 0; bj < 2; ++bj) { const size_t off = (size_t)row * D + col0 + bj * 128;
                    const pg8::f32x4 a0 = *(const pg8::f32x4*)(xi + off), a1 = *(const pg8::f32x4*)(xi + off + 4);
                    const pg8::f32x4 v0 = acc[ai][bj][m][0] + a0, v1 = acc[ai][bj][m][1] + a1;
                    *(pg8::f32x4*)(xo + off) = v0; *(pg8::f32x4*)(xo + off + 4) = v1;
                    q += (v0[0] * v0[0] + v0[1] * v0[1]) + (v0[2] * v0[2] + v0[3] * v0[3]) + (v1[0] * v1[0] + v1[1] * v1[1]) + (v1[2] * v1[2] + v1[3] * v1[3]);
                    u32x4 w; w.x = pg8::cvt_pk_bf16(v0[0], v0[1]); w.y = pg8::cvt_pk_bf16(v0[2], v0[3]); w.z = pg8::cvt_pk_bf16(v1[0], v1[1]); w.w = pg8::cvt_pk_bf16(v1[2], v1[3]);
                    *(u32x4*)(xb + off) = w; }
                q += __shfl_xor(q, 16); q += __shfl_xor(q, 32);
                if (fq == 0) ssq[(size_t)row * 16 + u.pn * 4 + wc] = q; }
    }
};

__device__ __forceinline__ void transpose_item(const float* W, const float* g, int K, int N, bf16* WT, LAS float* scr, int item, int lane) {
    const int nblk = N / 32, kb = item / nblk, nb = item % nblk, k0 = 64 * kb, n0 = 32 * nb;
#pragma unroll 8
    for (int i = 0; i < 32; ++i) { const int kk = 2 * i + (lane >> 5); const float sc = g ? g[k0 + kk] : 1.0f; scr[kk * 33 + (lane & 31)] = W[(size_t)(k0 + kk) * N + n0 + (lane & 31)] * sc; }
    asm volatile("s_waitcnt lgkmcnt(0)" ::: "memory");
    const int c = lane & 7;
#pragma unroll
    for (int j = 0; j < 4; ++j) { const int n = (lane >> 3) + 8 * j; const LAS float* s = scr + (8 * c) * 33 + n;
        u32x4 o; o.x = pk2(s[0 * 33], s[1 * 33]); o.y = pk2(s[2 * 33], s[3 * 33]); o.z = pk2(s[4 * 33], s[5 * 33]); o.w = pk2(s[6 * 33], s[7 * 33]);
        *(u32x4*)(WT + (size_t)(n0 + n) * K + k0 + 8 * c) = o; }
    asm volatile("s_waitcnt lgkmcnt(0)" ::: "memory");
}
__device__ __forceinline__ void ph_wconv(const P& p, unsigned char* lds, int bid, int G) {
    const int tid = threadIdx.x, lane = tid & 63, wave = tid >> 6;
    LAS float* scr = (LAS float*)((LAS unsigned char*)lds + wave * 16384);
    const int gw = bid * 8 + wave, NGW = G * 8;
    for (int it = gw; it < 2 * 6016; it += NGW) {
        const int l = it / 6016; int r = it % 6016; unsigned char* wb = p.ws + WS_W + (size_t)l * W_LAYER;
        if (r < 1408) { transpose_item(p.in[2] + (size_t)l * D * INW, p.in[1] + l * D, D, INW, (bf16*)(wb + W_IN), scr, r, lane); continue; } r -= 1408;
        if (r < 512) { transpose_item(p.in[9] + (size_t)l * D * D, nullptr, D, D, (bf16*)(wb + W_OUT), scr, r, lane); continue; } r -= 512;
        if (r < 2048) { transpose_item(p.in[11] + (size_t)l * D * FF, p.in[10] + l * D, D, FF, (bf16*)(wb + W_F1), scr, r, lane); continue; } r -= 2048;
        transpose_item(p.in[12] + (size_t)l * FF * D, nullptr, FF, D, (bf16*)(wb + W_F2), scr, r, lane);
    }
}
__device__ __forceinline__ void ph_xprep(const P& p, int bid, int G) {
    const int tid = threadIdx.x, lane = tid & 63, wave = tid >> 6; const int gw = bid * 8 + wave, NGW = G * 8;
    const float* x = p.in[0]; bf16* xb = (bf16*)(p.ws + WS_XB); float* ssq = (float*)(p.ws + WS_SSQ);
    for (int m = gw; m < M; m += NGW) {
        const f32x4* xr = (const f32x4*)(x + (size_t)m * D) + lane; f32x4 v[4]; float s = 0.f;
#pragma unroll
        for (int j = 0; j < 4; ++j) { v[j] = xr[64 * j]; s += (v[j].x * v[j].x + v[j].y * v[j].y) + (v[j].z * v[j].z + v[j].w * v[j].w); }
        s = wave_sum(s);
        unsigned long long* o8 = (unsigned long long*)(xb + (size_t)m * D) + lane;
#pragma unroll
        for (int j = 0; j < 4; ++j) o8[64 * j] = (unsigned long long)pk2(v[j].x, v[j].y) | ((unsigned long long)pk2(v[j].z, v[j].w) << 32);
        if (lane < 16) ssq[(size_t)m * 16 + lane] = lane == 0 ? s : 0.f;
    }
    float2* rope = (float2*)(p.ws + WS_ROPE);
    for (int i = bid * 512 + tid; i < S * 16; i += G * 512) { const int pos = i >> 4, k = i & 15;
        const float e = (float)k / 15.0f; const float inv = 1.0f / powf(10000.0f, e); const float ang = (float)pos * inv;
        rope[i] = make_float2((float)cos((double)ang), (float)sin((double)ang)); }
}
__device__ __forceinline__ void ph_prep_u(const P& p, int bid, int G) {
    const int tid = threadIdx.x; bf16* u = (bf16*)(p.ws + WS_U); const float2* rope = (const float2*)(p.ws + WS_ROPE);
    const float* qg = p.in[7] + p.layer * 64; const float* kg = p.in[8] + p.layer * 64;
    const long total = (long)M * 144;
    for (long idx = (long)bid * 512 + tid; idx < total; idx += (long)G * 512) {
        const int row = (int)(idx / 144), c = (int)(idx % 144);
        int col; if (c < 24) col = C_RQ + c * 8; else if (c < 48) col = C_RK + (c - 24) * 8; else if (c < 96) col = C_AQ + (c - 48) * 8; else col = C_AK + (c - 96) * 8;
        u32x4* ptr = (u32x4*)(u + (size_t)row * INW + col); float v[8], o[8]; unpack8(*ptr, v);
        float ss = 0.f;
#pragma unroll
        for (int t = 0; t < 8; ++t) ss += v[t] * v[t];
        ss += __shfl_xor(ss, 1); ss += __shfl_xor(ss, 2); ss += __shfl_xor(ss, 4);
        if (c < 48) { const int j = c & 3, pos = row & (S - 1); const float2* t4 = rope + pos * 16 + j * 4; const float sc = c >= 24 ? 0.17677669529663687f : 1.0f;
#pragma unroll
            for (int t = 0; t < 4; ++t) { const float2 cs = t4[t]; const float x1 = v[2 * t], x2 = v[2 * t + 1]; o[2 * t] = (x1 * cs.x - x2 * cs.y) * sc; o[2 * t + 1] = (x1 * cs.y + x2 * cs.x) * sc; }
        } else { const float r = (1.0f / sqrtf(ss * (1.0f / 64.0f) + EPS)) * (c < 96 ? 0.125f : 1.0f); const float* g = (c < 96 ? qg : kg) + (c & 7) * 8;
#pragma unroll
            for (int t = 0; t < 8; ++t) o[t] = v[t] * r * g[t]; }
        *ptr = pack8(o);
    }
}
__device__ __forceinline__ void ph_conv(const P& p, unsigned char* lds, int bid, int G) {
    const int tid = threadIdx.x; const bf16* u = (const bf16*)(p.ws + WS_U); bf16* mix = (bf16*)(p.ws + WS_MIX);
    float* hl = (float*)lds;
    const int c = tid & 255, half = tid >> 8; const int l = p.layer;
    float W[31];
#pragma unroll
    for (int w = 0; w < 31; ++w) W[w] = p.in[3][(size_t)l * 31 * 256 + w * 256 + c];
    const float bias = p.in[4][l * 256 + c], gain = p.in[5][l * 256 + c];
    for (int unit = bid; unit < M / 32; unit += G) {
        const int b = unit / (S / 32), t0 = (unit % (S / 32)) * 32;
        for (int task = tid; task < 62 * 32; task += 512) { const int r = task >> 5, c8 = (task & 31) * 8; const int tok = t0 - 30 + r; float h[8];
            if (tok >= 0) { const bf16* up = u + (size_t)(b * S + tok) * INW + c8; float a[8], g[8]; unpack8(*(const u32x4*)(up + C_A), a); unpack8(*(const u32x4*)(up + C_G), g);
#pragma unroll
                for (int t = 0; t < 8; ++t) h[t] = a[t] / (1.0f + __expf(-g[t])); }
            else {
#pragma unroll
                for (int t = 0; t < 8; ++t) h[t] = 0.f; }
            *(f32x4*)(hl + r * 256 + c8) = (f32x4){h[0], h[1], h[2], h[3]}; *(f32x4*)(hl + r * 256 + c8 + 4) = (f32x4){h[4], h[5], h[6], h[7]}; }
        __syncthreads();
        for (int tt = 0; tt < 16; ++tt) { const int t = half * 16 + tt; float acc = bias;
#pragma unroll
            for (int w = 0; w < 31; ++w) acc += W[w] * hl[(t + w) * 256 + c];
            const float ss = wave_sum(acc * acc); float y = acc * (1.0f / sqrtf(ss * (1.0f / 64.0f) + EPS)) * gain; y = y / (1.0f + __expf(-y));
            mix[(size_t)(b * S + t0 + t) * D + MX_CONV + c] = (bf16)f2bf(y); }
        __syncthreads();
    }
}
__device__ __forceinline__ void ph_ret1(const P& p, unsigned char* lds, int bid, int G) {
    const int tid = threadIdx.x; const bf16* u = (const bf16*)(p.ws + WS_U); float* kv = (float*)(p.ws + WS_KV);
    float* kd = (float*)lds; float* vv = kd + 128 * 32;
    for (int unit = bid; unit < 1536; unit += G) {
        const int bh = unit >> 7, n = unit & 127, b = bh / 6, h = bh % 6; const size_t row0 = (size_t)b * S + n * 128; const float l2g = gamma_log2(h);
        { const int j = tid >> 2, c8 = (tid & 3) * 8; float k[8]; unpack8(*(const u32x4*)(u + (row0 + j) * INW + C_RK + h * 32 + c8), k); const float dec = exp2f((float)(127 - j) * l2g);
#pragma unroll
          for (int t = 0; t < 8; ++t) kd[j * 32 + c8 + t] = k[t] * dec;
          const int c16 = (tid & 3) * 16; float a[8], bq[8]; const bf16* vp = u + (row0 + j) * INW + C_RV + h * 64 + c16; unpack8(*(const u32x4*)vp, a); unpack8(*(const u32x4*)(vp + 8), bq);
#pragma unroll
          for (int t = 0; t < 8; ++t) { vv[j * 64 + c16 + t] = a[t]; vv[j * 64 + c16 + 8 + t] = bq[t]; } }
        __syncthreads();
        const int d = tid >> 4, e4 = (tid & 15) * 4; f32x4 acc = {0.f, 0.f, 0.f, 0.f};
        for (int j = 0; j < 128; ++j) acc += kd[j * 32 + d] * *(const f32x4*)(vv + j * 64 + e4);
        *(f32x4*)(kv + (size_t)unit * 2048 + d * 64 + e4) = acc;
        __syncthreads();
    }
}
__device__ __forceinline__ void ph_ret2(const P& p, int bid, int G) {
    const float* kv = (const float*)(p.ws + WS_KV); float* st = (float*)(p.ws + WS_ST);
    for (int idx = bid * 512 + threadIdx.x; idx < 12 * 2048; idx += G * 512) { const int bh = idx >> 11, de = idx & 2047, h = bh % 6; const float cd = exp2f(128.0f * gamma_log2(h)); float s = 0.f;
        for (int n = 0; n < 128; ++n) { const size_t o = ((size_t)(bh * 128 + n)) * 2048 + de; st[o] = s; s = s * cd + kv[o]; } }
}
__device__ __forceinline__ void ph_ret3(const P& p, unsigned char* lds, int bid, int G) {
    const int tid = threadIdx.x; const bf16* u = (const bf16*)(p.ws + WS_U); bf16* mix = (bf16*)(p.ws + WS_MIX); const float* stg = (const float*)(p.ws + WS_ST);
    float* ql = (float*)lds; float* kl = ql + 128 * 32; float* vl = kl + 128 * 32; float* sl = vl + 128 * 64;
    const float* retg = p.in[6] + p.layer * 384;
    for (int unit = bid; unit < 1536; unit += G) {
        const int bh = unit >> 7, n = unit & 127, b = bh / 6, h = bh % 6; const size_t row0 = (size_t)b * S + n * 128; const float l2g = gamma_log2(h);
        { const int j = tid >> 2, c8 = (tid & 3) * 8; float a[8], bq[8]; const bf16* up = u + (row0 + j) * INW;
          unpack8(*(const u32x4*)(up + C_RQ + h * 32 + c8), a); unpack8(*(const u32x4*)(up + C_RK + h * 32 + c8), bq);
#pragma unroll
          for (int t = 0; t < 8; ++t) { ql[j * 32 + c8 + t] = a[t]; kl[j * 32 + c8 + t] = bq[t]; }
          const int c16 = (tid & 3) * 16; unpack8(*(const u32x4*)(up + C_RV + h * 64 + c16), a); unpack8(*(const u32x4*)(up + C_RV + h * 64 + c16 + 8), bq);
#pragma unroll
          for (int t = 0; t < 8; ++t) { vl[j * 64 + c16 + t] = a[t]; vl[j * 64 + c16 + 8 + t] = bq[t]; }
          *(f32x4*)(sl + tid * 4) = *(const f32x4*)(stg + (size_t)unit * 2048 + tid * 4); }
        __syncthreads();
        const int i = tid >> 2, e0 = (tid & 3) * 16; f32x4 q[8];
#pragma unroll
        for (int t = 0; t < 8; ++t) q[t] = *(const f32x4*)(ql + i * 32 + 4 * t);
        f32x4 acc[4] = {{0.f, 0.f, 0.f, 0.f}, {0.f, 0.f, 0.f, 0.f}, {0.f, 0.f, 0.f, 0.f}, {0.f, 0.f, 0.f, 0.f}};
        for (int j = 0; j <= i; ++j) { float s = 0.f;
#pragma unroll
            for (int t = 0; t < 8; ++t) { const f32x4 kk = *(const f32x4*)(kl + j * 32 + 4 * t); s += (q[t].x * kk.x + q[t].y * kk.y) + (q[t].z * kk.z + q[t].w * kk.w); }
            s *= exp2f((float)(i - j) * l2g);
#pragma unroll
            for (int t = 0; t < 4; ++t) acc[t] += s * *(const f32x4*)(vl + j * 64 + e0 + 4 * t); }
        const float cw = exp2f((float)(i + 1) * l2g);
#pragma unroll
        for (int t = 0; t < 8; ++t)
#pragma unroll
            for (int k = 0; k < 4; ++k) { const float qd = q[t][k] * cw; const int d = 4 * t + k;
#pragma unroll
                for (int t2 = 0; t2 < 4; ++t2) acc[t2] += qd * *(const f32x4*)(sl + d * 64 + e0 + 4 * t2); }
        float ss = 0.f;
#pragma unroll
        for (int t = 0; t < 4; ++t) ss += (acc[t].x * acc[t].x + acc[t].y * acc[t].y) + (acc[t].z * acc[t].z + acc[t].w * acc[t].w);
        ss += __shfl_xor(ss, 1); ss += __shfl_xor(ss, 2);
        const float r = 1.0f / sqrtf(ss * (1.0f / 64.0f) + EPS);
        float g[16]; { float a[8], bq[8]; const bf16* gp = u + (row0 + i) * INW + C_RG + h * 64 + e0; unpack8(*(const u32x4*)gp, a); unpack8(*(const u32x4*)(gp + 8), bq);
#pragma unroll
            for (int t = 0; t < 8; ++t) { g[t] = a[t]; g[8 + t] = bq[t]; } }
        float o[16];
#pragma unroll
        for (int t = 0; t < 16; ++t) { const float gv = g[t]; o[t] = acc[t >> 2][t & 3] * r * retg[h * 64 + e0 + t] * (gv / (1.0f + __expf(-gv))); }
        bf16* mp = mix + (row0 + i) * D + MX_RET + h * 64 + e0; float o0[8], o1[8];
#pragma unroll
        for (int t = 0; t < 8; ++t) { o0[t] = o[t]; o1[t] = o[8 + t]; }
        *(u32x4*)mp = pack8(o0); *(u32x4*)(mp + 8) = pack8(o1);
        __syncthreads();
    }
}
__device__ __forceinline__ void ph_attn_naive(const P& p, unsigned char* lds, int bid, int G) {
    const int tid = threadIdx.x; const bf16* u = (const bf16*)(p.ws + WS_U); bf16* mix = (bf16*)(p.ws + WS_MIX);
    float* btab = (float*)lds;
    const float* rel_bias = p.in[13];
    for (int i = tid; i < 6 * 387; i += 512) { const int h = i / 387, r = i % 387, br = r / 129, dist = r % 129; const int dl = br == 0 ? 1 : (br == 1 ? 4 : 16); const int n = dist * dl; int bucket;
        if (n < 16) bucket = n; else { const float nf = (float)n; int lg = 16 + (int)(logf(nf / 16.0f) / 4.852030263919617f * 16.0f); bucket = lg < 31 ? lg : 31; }
        btab[i] = rel_bias[bucket * 6 + h]; }
    __syncthreads();
    for (int unit = bid; unit < 384; unit += G) {
        const int b = unit / 192, h = (unit / 32) % 6, qt = unit % 32; const int pos = qt * 512 + tid; const size_t row = (size_t)b * S + pos;
        float q[64], acc[64];
        { const u32x4* qp = (const u32x4*)(u + row * INW + C_AQ + h * 64);
#pragma unroll
          for (int t = 0; t < 8; ++t) { float v[8]; unpack8(qp[t], v);
#pragma unroll
              for (int k = 0; k < 8; ++k) { q[8 * t + k] = v[k]; acc[8 * t + k] = 0.f; } } }
        float mx = -1e30f, l = 0.f;
        for (int br = 0; br < 3; ++br) { const int dl = br == 0 ? 1 : (br == 1 ? 4 : 16); const float* bt = btab + h * 387 + br * 129;
            for (int dist = 0; dist <= 128; ++dist) { const int kp = pos - dist * dl; if (kp < 0) break;
                const bf16* kr = u + ((size_t)b * S + kp) * INW; const u32x4* kq = (const u32x4*)(kr + C_AK + h * 64); const u32x4* vq = (const u32x4*)(kr + C_AV + h * 64);
                float s = bt[dist];
#pragma unroll
                for (int t = 0; t < 8; ++t) { float v[8]; unpack8(kq[t], v);
#pragma unroll
                    for (int k = 0; k < 8; ++k) s += q[8 * t + k] * v[k]; }
                if (s > mx) { const float f = __expf(mx - s); l *= f;
#pragma unroll
                    for (int k = 0; k < 64; ++k) acc[k] *= f;
                    mx = s; }
                const float pw = __expf(s - mx); l += pw;
#pragma unroll
                for (int t = 0; t < 8; ++t) { float v[8]; unpack8(vq[t], v);
#pragma unroll
                    for (int k = 0; k < 8; ++k) acc[8 * t + k] += pw * v[k]; } } }
        const float inv = 1.0f / l; u32x4* op = (u32x4*)(mix + row * D + MX_ATT + h * 64);
#pragma unroll
        for (int t = 0; t < 8; ++t) { float v[8];
#pragma unroll
            for (int k = 0; k < 8; ++k) v[k] = acc[8 * t + k] * inv;
            op[t] = pack8(v); }
    }
}
template <int WHICH> __device__ __forceinline__ void ph_gemm(const P& p, unsigned char* lds, int bid, int G) {
    unsigned char* wb = p.ws + WS_W + (size_t)p.layer * W_LAYER; float* ssq = (float*)(p.ws + WS_SSQ); bf16* xb = (bf16*)(p.ws + WS_XB);
    pg8::StaticOrder So;
    if constexpr (WHICH == 0) { pg8::Gemm g{xb, (const bf16*)(wb + W_IN), M, INW, D}; So.init(M, INW, G, bid); EpiNormBf16<0> E{(bf16*)(p.ws + WS_U), ssq, INW, 0};
        pg8::gemm_phase<EpiNormBf16<0>, pg8::StaticOrder, true, true>((LAS unsigned char*)lds, g, So, E); }
    if constexpr (WHICH == 1) { pg8::Gemm g{(const bf16*)(p.ws + WS_MIX), (const bf16*)(wb + W_OUT), M, D, D}; So.init(M, D, G, bid); EpiRes E{p.layer == 0 ? p.in[0] : p.out, p.out, xb, ssq};
        pg8::gemm_phase<EpiRes, pg8::StaticOrder, true, true>((LAS unsigned char*)lds, g, So, E); }
    if constexpr (WHICH == 2) { pg8::Gemm g{xb, (const bf16*)(wb + W_F1), M, FF, D}; So.init(M, FF, G, bid); EpiNormBf16<1> E{(bf16*)(p.ws + WS_H), ssq, FF, 0};
        pg8::gemm_phase<EpiNormBf16<1>, pg8::StaticOrder, true, true>((LAS unsigned char*)lds, g, So, E); }
    if constexpr (WHICH == 3) { pg8::Gemm g{(const bf16*)(p.ws + WS_H), (const bf16*)(wb + W_F2), M, D, FF}; So.init(M, D, G, bid); EpiRes E{p.out, p.out, xb, ssq};
        pg8::gemm_phase<EpiRes, pg8::StaticOrder, true, true>((LAS unsigned char*)lds, g, So, E); }
}

enum { PH_WCONV = 0, PH_XPREP, PH_GEMM_IN, PH_PREP_U, PH_CONV, PH_RET1, PH_RET2, PH_RET3, PH_ATTN, PH_GEMM_OUT, PH_GEMM_FF1, PH_GEMM_FF2, PH_COUNT };
template <int PH> __device__ __forceinline__ void run_phase(const P& p, unsigned char* lds, int bid, int G) {
    if constexpr (PH == PH_WCONV) ph_wconv(p, lds, bid, G);
    if constexpr (PH == PH_XPREP) ph_xprep(p, bid, G);
    if constexpr (PH == PH_GEMM_IN) ph_gemm<0>(p, lds, bid, G);
    if constexpr (PH == PH_PREP_U) ph_prep_u(p, bid, G);
    if constexpr (PH == PH_CONV) ph_conv(p, lds, bid, G);
    if constexpr (PH == PH_RET1) ph_ret1(p, lds, bid, G);
    if constexpr (PH == PH_RET2) ph_ret2(p, bid, G);
    if constexpr (PH == PH_RET3) ph_ret3(p, lds, bid, G);
    if constexpr (PH == PH_ATTN) ph_attn_naive(p, lds, bid, G);
    if constexpr (PH == PH_GEMM_OUT) ph_gemm<1>(p, lds, bid, G);
    if constexpr (PH == PH_GEMM_FF1) ph_gemm<2>(p, lds, bid, G);
    if constexpr (PH == PH_GEMM_FF2) ph_gemm<3>(p, lds, bid, G);
}
template <int PH> __global__ void __launch_bounds__(512, 2) k_phase(P p) {
    extern __shared__ __attribute__((aligned(16))) unsigned char lds[];
    run_phase<PH>(p, lds, (int)blockIdx.x, (int)gridDim.x);
}
constexpr int LDS_GEMM = 131072;
template <int PH> static void launch_phase(const P& p, int grid, int ldsb, hipStream_t stream) {
    static bool attr = false;
    if (!attr) { (void)hipFuncSetAttribute((const void*)k_phase<PH>, hipFuncAttributeMaxDynamicSharedMemorySize, LDS_GEMM); attr = true; }
    hipLaunchKernelGGL(k_phase<PH>, dim3(grid), dim3(512), ldsb, stream, p);
}
extern "C" void kernel_launch(void* const* d_in, const int* in_sizes, int n_in, void* d_out, int out_size, void* d_ws, size_t ws_size, hipStream_t stream) {
    if (n_in != 14 || in_sizes[0] != M * D || out_size != M * D || ws_size < WS_END) { fprintf(stderr, "kernel_launch: unexpected shapes (n_in %d, in0 %d, out %d, ws %zu)\n", n_in, n_in > 0 ? in_sizes[0] : -1, out_size, ws_size); return; }
    P p{}; for (int i = 0; i < 14; ++i) p.in[i] = (const float*)d_in[i];
    p.out = (float*)d_out; p.ws = (unsigned char*)d_ws; p.layer = 0; p.pad = 0;
    launch_phase<PH_WCONV>(p, 256, LDS_GEMM, stream);
    launch_phase<PH_XPREP>(p, 1024, 0, stream);
    for (int l = 0; l < DEPTH; ++l) { p.layer = l;
        launch_phase<PH_GEMM_IN>(p, 256, LDS_GEMM, stream);
        launch_phase<PH_PREP_U>(p, 2048, 0, stream);
        launch_phase<PH_CONV>(p, 1024, 62 * 256 * 4, stream);
        launch_phase<PH_RET1>(p, 1536, 49152, stream);
        launch_phase<PH_RET2>(p, 48, 0, stream);
        launch_phase<PH_RET3>(p, 1536, 73728, stream);
        launch_phase<PH_ATTN>(p, 384, 16384, stream);
        launch_phase<PH_GEMM_OUT>(p, 256, LDS_GEMM, stream);
        launch_phase<PH_GEMM_FF1>(p, 256, LDS_GEMM, stream);
        launch_phase<PH_GEMM_FF2>(p, 256, LDS_GEMM, stream);
    }
}
```

```cpp
#include <hip/hip_runtime.h>
#include <hip/hip_cooperative_groups.h>
#include <cstdio>
#include <cstdint>
namespace cg = cooperative_groups;
#define GAS __attribute__((address_space(1)))
#define LAS __attribute__((address_space(3)))
typedef GAS unsigned gu32;
#define XB_TMO      128
#define XB_XCNT(j)  (256  + 64 * (j))
#define XB_XSUB(j)  (1280 + 64 * (j))
#define XB_XGEN(j)  (2304 + 64 * (j))
#define XB_TOP      3328
#define XB_TOPGEN   3392
#define XCD_BAR_WORDS 3456
#define XB_SPIN_CAP (1u << 21)

__device__ __forceinline__ unsigned xb_ld(unsigned* p)              { return __hip_atomic_load(p, __ATOMIC_RELAXED, __HIP_MEMORY_SCOPE_AGENT); }
__device__ __forceinline__ unsigned xb_add(unsigned* p, unsigned v) { return __hip_atomic_fetch_add(p, v, __ATOMIC_RELAXED, __HIP_MEMORY_SCOPE_AGENT); }
__device__ __forceinline__ unsigned xb_xcc_id() { return (unsigned)__builtin_amdgcn_s_getreg((3 << 11) | 20) & 0xFu; }
#define XB_SPIN(cond, bar) do { unsigned _sp = 0; while (cond) { __builtin_amdgcn_s_sleep(1); \
    if ((++_sp & 255u) == 0u) { if (xb_ld(&(bar)[XB_TMO])) break; if (_sp > XB_SPIN_CAP) { atomicAdd(&(bar)[XB_TMO], 1u); break; } } } } while (0)

struct XcdBarrier {
    unsigned* bar; unsigned x;
    volatile LAS unsigned* st;
};

__device__ __forceinline__ XcdBarrier xcd_barrier_post(unsigned* bar, volatile LAS unsigned* st) {
    XcdBarrier b; b.bar = bar; b.x = xb_xcc_id(); b.st = st;
    if (threadIdx.x == 0) (void)xb_add(&bar[XB_XCNT(b.x)], 1u);
    return b;
}
__device__ __forceinline__ void xcd_barrier_complete(unsigned* bar, unsigned x, unsigned& nloc, unsigned& nx) {
    const unsigned G = gridDim.x * gridDim.y * gridDim.z;
    unsigned sum, cnt, mine, sp = 0u;
    for (;;) {
        sum = 0u; cnt = 0u; mine = 0u;
#pragma unroll
        for (unsigned j = 0; j < 16; ++j) { const unsigned c = xb_ld(&bar[XB_XCNT(j)]); sum += c; cnt += (c > 0u) ? 1u : 0u; mine = (j == x) ? c : mine; }
        if (sum == G) break;
        __builtin_amdgcn_s_sleep(1);
        if ((++sp & 255u) == 0u) { if (xb_ld(&bar[XB_TMO])) break; if (sp > XB_SPIN_CAP) { atomicAdd(&bar[XB_TMO], 1u); break; } }
    }
    nloc = mine > 0u ? mine : 1u; nx = cnt > 0u ? cnt : 1u;
}

__device__ __forceinline__ void xcd_barrier(const XcdBarrier& b) {
    asm volatile("s_waitcnt vmcnt(0)" ::: "memory");
    __syncthreads();
    if (threadIdx.x == 0) {
        unsigned* bar = b.bar;
        __builtin_amdgcn_s_waitcnt(0);
        unsigned nloc = b.st[0], nx = b.st[1];
        if (nloc == 0u) { xcd_barrier_complete(bar, b.x, nloc, nx); b.st[0] = nloc; b.st[1] = nx; }
        const unsigned old = xb_add(&bar[XB_XSUB(b.x)], 1u);
        const unsigned gen = old / nloc;
        if (old + 1u == (gen + 1u) * nloc) {
            __builtin_amdgcn_fence(__ATOMIC_RELEASE, "agent");
            asm volatile("s_waitcnt vmcnt(0)" ::: "memory");
            const unsigned og = xb_add(&bar[XB_TOP], 1u);
            const unsigned tg = og / nx;
            if (og + 1u == (tg + 1u) * nx) xb_add(&bar[XB_TOPGEN], 1u);
            else XB_SPIN(xb_ld(&bar[XB_TOPGEN]) == tg, bar);
            __builtin_amdgcn_fence(__ATOMIC_ACQUIRE, "agent");
            xb_add(&bar[XB_XGEN(b.x)], 1u);
            asm volatile("s_waitcnt vmcnt(0)" ::: "memory");
        } else {
            XB_SPIN(xb_ld(&bar[XB_XGEN(b.x)]) == gen, bar);
            __builtin_amdgcn_fence(__ATOMIC_ACQUIRE, "agent");
            asm volatile("s_waitcnt vmcnt(0)" ::: "memory");
        }
    }
    __syncthreads();
}

#define XB_EV_WORDS 1088
__device__ __forceinline__ void split_arrive(const XcdBarrier& b, unsigned* ev) {
    asm volatile("s_waitcnt vmcnt(0)" ::: "memory");
    __syncthreads();
    if (threadIdx.x == 0) {
        unsigned nloc = b.st[0], nx = b.st[1];
        if (nloc == 0u) { xcd_barrier_complete(b.bar, b.x, nloc, nx); b.st[0] = nloc; b.st[1] = nx; }
        const unsigned old = xb_add(&ev[64u * (1u + b.x)], 1u);
        if (old + 1u == nloc) { __builtin_amdgcn_fence(__ATOMIC_RELEASE, "agent"); asm volatile("s_waitcnt vmcnt(0)" ::: "memory"); (void)xb_add(&ev[0], nloc); }
    }
}
__device__ __forceinline__ void split_wait(unsigned* ctr, unsigned G, unsigned* bar) {
    if (threadIdx.x == 0) { XB_SPIN(xb_ld(ctr) < G, bar); __builtin_amdgcn_fence(__ATOMIC_ACQUIRE, "agent"); asm volatile("s_waitcnt vmcnt(0)" ::: "memory"); }
    __syncthreads();
}
namespace pg8 {
#define PG8_LAS __attribute__((address_space(3)))
typedef unsigned short bf16_t;
typedef short bf16x8 __attribute__((ext_vector_type(8)));
typedef float f32x4 __attribute__((ext_vector_type(4)));
typedef unsigned u32x4 __attribute__((ext_vector_type(4)));
constexpr int BM = 256, BK = 64, HALF = 128, HTB = HALF * BK * 2  , STAGE_BYTES = 8 * HTB, NXCD = 8, WGM = 8;

__host__ __device__ __forceinline__ int lds_byte(int r, int c) { const int st = (r >> 4) * 2 + (c >> 5), rr = r & 15, cc = c & 31, ob = rr * 64 + cc * 2; return st * 1024 + (ob ^ (((ob >> 9) & 1) << 5)); }
__host__ __device__ __forceinline__ void stage_rc(int b, int& R, int& C) { const int st = b / 1024, sb = b % 1024, swz = sb ^ (((sb >> 9) & 1) << 5); R = (st >> 1) * 16 + swz / 64; C = (st & 1) * 32 + (swz % 64) / 2; }
__host__ __device__ __forceinline__ int perm32(int rho) { const int n = rho >> 4, i = rho & 15; return 8 * (i >> 2) + 4 * n + (i & 3); }

struct Unit { int pm, pn; };
struct Gemm { const bf16_t* A; const bf16_t* Bt; int M, N, K, lda; };

struct StaticOrder {
    int nM, nN, nwg, G, c, convfirst; unsigned* arr; const XcdBarrier* xbp; mutable int ndone;
    __host__ __device__ void init(int M, int N, int G_, int c_, int convfirst_ = 0, unsigned* arr_ = nullptr, const XcdBarrier* xbp_ = nullptr) { nM = M / BM; nN = N / BM; nwg = nM * nN; G = G_; c = c_; convfirst = convfirst_; arr = arr_; xbp = xbp_; ndone = 0; }
    __host__ __device__ bool next(int i, Unit& u) const {
        const long L = (long)i * G + c; if (L >= nwg) return false;
        if (convfirst) {
            const int xcd = (int)(L % NXCD), off = (int)(L / NXCD), per = nM / NXCD;
            if (off < 2 * per) { u.pm = xcd * per + off % per; u.pn = off / per; }
            else { const int o2 = off - 2 * per, gs = WGM * (nN - 2), grp = o2 / gs, w = o2 % gs; u.pm = xcd * per + grp * WGM + w % WGM; u.pn = 2 + w / WGM; }
            return true; }
        int wgid = (int)L; { const int q = nwg / NXCD, r = nwg % NXCD, xcd = wgid % NXCD, off = wgid / NXCD; wgid = (xcd < r ? xcd * (q + 1) : r * (q + 1) + (xcd - r) * q) + off; }
        const int nig = WGM * nN, gid = wgid / nig, fm = gid * WGM, gsz = (nM - fm) < WGM ? (nM - fm) : WGM;
        u.pm = fm + ((wgid % nig) % gsz); u.pn = (wgid % nig) / gsz; return true;
    }
    __device__ __forceinline__ void a_ready(const Unit&) const {}
    __device__ __forceinline__ void done(const Unit&) const { if (arr != nullptr && ndone++ == 0) split_arrive(*xbp, arr); }
};

__device__ __forceinline__ unsigned cvt_pk_bf16(float lo, float hi) { unsigned r; asm volatile("v_cvt_pk_bf16_f32 %0, %1, %2" : "=v"(r) : "v"(lo), "v"(hi)); return r; }
typedef float f32x2 __attribute__((ext_vector_type(2)));
template <class Epi, class Sched, bool ALIGN_EPI = false, bool SP2 = false>
__device__ __forceinline__ void gemm_phase(PG8_LAS unsigned char* lds, const Gemm g, const Sched& S, const Epi& E) {
    int tid_ = threadIdx.x; asm volatile("" : "+v"(tid_)); const int tid = tid_, wid = __builtin_amdgcn_readfirstlane(tid >> 6), lane = tid & 63, wr = wid >> 2, wc = wid & 3, fr = lane & 15, fq = lane >> 4;
    const int K = g.K, nt = K / BK;
    unsigned voffA[2], voffB[2];
#pragma unroll
    for (int i = 0; i < 2; ++i) { int R, C; stage_rc(tid * 16 + i * 8192, R, C); const int Rb = Epi::PERM ? (2 * (R & ~31) + perm32(R & 31)) : R;
        voffA[i] = (unsigned)(R * g.lda + C) * 2u; voffB[i] = (unsigned)(Rb * K + C) * 2u; }
    const size_t kstep = (size_t)(BK * 2);
    const size_t hstep = (size_t)HALF * g.lda * 2;
    const size_t tstep = 2 * hstep, tstepB = (size_t)BM * K * 2;
    const size_t hstepB = Epi::PERM ? (size_t)32 * K * 2 : (size_t)HALF * K * 2;
    const unsigned ldsw = (unsigned)wid * 1024u;
    const int aoff = lds_byte(wr * 64 + fr, fq * 8), boff = lds_byte(wc * 32 + fr, fq * 8);
#define PG8_SA(b, h) (((b) * 2 + (h)) * HTB)
#define PG8_SB(b, h) ((4 + (b) * 2 + (h)) * HTB)
#define PG8_STAGE(bufoff, gbase, voff) do { _Pragma("unroll") for (int _i = 0; _i < 2; ++_i) \
        __builtin_amdgcn_global_load_lds((const unsigned*)((const char*)(gbase) + (voff)[_i]), (PG8_LAS unsigned*)(lds + (bufoff) + ldsw + _i * 8192), 16, 0, 0); } while (0)
#define PG8_LDA(dst, b, h) do { _Pragma("unroll") for (int m = 0; m < 4; ++m) _Pragma("unroll") for (int k = 0; k < 2; ++k) dst[m][k] = *(const PG8_LAS bf16x8*)(lds + PG8_SA(b, h) + aoff + m * 2048 + k * 1024); } while (0)
#define PG8_LDB(dst, b, h) do { _Pragma("unroll") for (int n = 0; n < 2; ++n) _Pragma("unroll") for (int k = 0; k < 2; ++k) dst[n][k] = *(const PG8_LAS bf16x8*)(lds + PG8_SB(b, h) + boff + n * 2048 + k * 1024); } while (0)
#define PG8_MMA(ai, bj, At, Bt) do { __builtin_amdgcn_s_setprio(1); _Pragma("unroll") for (int m = 0; m < 4; ++m) _Pragma("unroll") for (int n = 0; n < 2; ++n) _Pragma("unroll") for (int k = 0; k < 2; ++k) \
        acc[ai][bj][m][n] = __builtin_amdgcn_mfma_f32_16x16x32_bf16(Bt[n][k], At[m][k], acc[ai][bj][m][n], 0, 0, 0); __builtin_amdgcn_s_setprio(0); } while (0)
#define PG8_WAIT_V(n) asm volatile("s_waitcnt vmcnt(" #n ")" ::: "memory")
#define PG8_WAIT_L(n) asm volatile("s_waitcnt lgkmcnt(" #n ")" ::: "memory")
#define PG8_BAR __builtin_amdgcn_s_barrier()
#define PG8_SCHED __builtin_amdgcn_sched_barrier(0)
    Unit cur, nxt; int ui = 0;
    if (!S.next(0, cur)) return;
    f32x4 acc[2][2][4][2];
#pragma unroll
    for (int a = 0; a < 2; ++a)
#pragma unroll
        for (int b = 0; b < 2; ++b)
#pragma unroll
            for (int m = 0; m < 4; ++m)
#pragma unroll
                for (int n = 0; n < 2; ++n) acc[a][b][m][n] = (f32x4){0.f, 0.f, 0.f, 0.f};
    bf16x8 At[4][2], B0[2][2], B1[2][2];
    const char* cA = (const char*)g.A + (size_t)cur.pm * tstep; const char* cB = (const char*)g.Bt + (size_t)cur.pn * tstepB;
    S.a_ready(cur);
    if constexpr (SP2) {
        PG8_STAGE(PG8_SB(0, 0), cB, voffB); PG8_STAGE(PG8_SB(0, 1), cB + hstepB, voffB); PG8_STAGE(PG8_SA(0, 0), cA, voffA); PG8_STAGE(PG8_SA(0, 1), cA + hstep, voffA);
        if (wr == 1) PG8_BAR;
        PG8_WAIT_V(2); PG8_BAR;
        PG8_STAGE(PG8_SB(1, 0), cB + kstep, voffB); PG8_STAGE(PG8_SA(1, 0), cA + kstep, voffA); PG8_STAGE(PG8_SB(1, 1), cB + hstepB + kstep, voffB);
        PG8_WAIT_V(6); PG8_BAR;
    } else {
        PG8_STAGE(PG8_SB(0, 0), cB, voffB); PG8_STAGE(PG8_SA(0, 0), cA, voffA); PG8_STAGE(PG8_SB(0, 1), cB + hstepB, voffB); PG8_STAGE(PG8_SA(0, 1), cA + hstep, voffA);
        if (wr == 1) PG8_BAR;
        PG8_WAIT_V(4); PG8_BAR;
        PG8_STAGE(PG8_SB(1, 0), cB + kstep, voffB); PG8_STAGE(PG8_SA(1, 0), cA + kstep, voffA); PG8_STAGE(PG8_SB(1, 1), cB + hstepB + kstep, voffB);
        PG8_WAIT_V(6); PG8_BAR;
    }
    for (;;) {
        const bool has_next = S.next(ui + 1, nxt);
        const char* nA = has_next ? (const char*)g.A + (size_t)nxt.pm * tstep : cA; const char* nB = has_next ? (const char*)g.Bt + (size_t)nxt.pn * tstepB : cB;
        for (int t = 0; t < nt; t += 2) {
            const bool last = (t == nt - 2);
            const char* a1 = cA + (size_t)(t + 1) * kstep;
            const char* a2 = last ? nA : cA + (size_t)(t + 2) * kstep; const char* b2 = last ? nB : cB + (size_t)(t + 2) * kstep;
            const char* a3 = a2 + kstep; const char* b3 = b2 + kstep;
            if (last && has_next) S.a_ready(nxt);
            if constexpr (SP2) {
            PG8_LDB(B0, 0, 0); PG8_LDB(B1, 0, 1); PG8_SCHED; PG8_LDA(At, 0, 0); PG8_STAGE(PG8_SA(1, 1), a1 + hstep, voffA);
            PG8_WAIT_V(8); PG8_WAIT_L(0); PG8_BAR; PG8_MMA(0, 0, At, B0); PG8_MMA(0, 1, At, B1); PG8_BAR; PG8_SCHED;
            PG8_LDA(At, 0, 1); PG8_STAGE(PG8_SB(0, 0), b2, voffB); PG8_STAGE(PG8_SB(0, 1), b2 + hstepB, voffB); PG8_STAGE(PG8_SA(0, 0), a2, voffA);
            PG8_WAIT_V(8); PG8_WAIT_L(0); PG8_BAR; PG8_MMA(1, 0, At, B0); PG8_MMA(1, 1, At, B1); PG8_BAR; PG8_SCHED;
            PG8_LDB(B0, 1, 0); PG8_LDB(B1, 1, 1); PG8_SCHED; PG8_LDA(At, 1, 0); PG8_STAGE(PG8_SA(0, 1), a2 + hstep, voffA);
            PG8_WAIT_V(8); PG8_WAIT_L(0); PG8_BAR; PG8_MMA(0, 0, At, B0); PG8_MMA(0, 1, At, B1); PG8_BAR; PG8_SCHED;
            PG8_LDA(At, 1, 1); PG8_STAGE(PG8_SB(1, 0), b3, voffB); PG8_STAGE(PG8_SB(1, 1), b3 + hstepB, voffB); PG8_STAGE(PG8_SA(1, 0), a3, voffA);
            PG8_WAIT_V(8); PG8_WAIT_L(0); PG8_BAR; PG8_MMA(1, 0, At, B0); PG8_MMA(1, 1, At, B1); PG8_BAR; PG8_SCHED;
            } else {
            PG8_LDB(B0, 0, 0); PG8_SCHED; PG8_LDA(At, 0, 0); PG8_STAGE(PG8_SA(1, 1), a1 + hstep, voffA);
            PG8_WAIT_L(8); PG8_BAR; PG8_WAIT_L(0); PG8_MMA(0, 0, At, B0); PG8_BAR; PG8_SCHED;
            PG8_LDB(B1, 0, 1); PG8_STAGE(PG8_SB(0, 0), b2, voffB);
            PG8_BAR; PG8_WAIT_L(0); PG8_MMA(0, 1, At, B1); PG8_BAR;
            PG8_LDA(At, 0, 1); PG8_STAGE(PG8_SA(0, 0), a2, voffA);
            PG8_BAR; PG8_WAIT_L(0); PG8_MMA(1, 0, At, B0); PG8_BAR; PG8_SCHED;
            PG8_STAGE(PG8_SB(0, 1), b2 + hstepB, voffB);
            PG8_WAIT_V(6); PG8_BAR; PG8_MMA(1, 1, At, B1); PG8_BAR;
            PG8_LDB(B0, 1, 0); PG8_SCHED; PG8_LDA(At, 1, 0); PG8_STAGE(PG8_SA(0, 1), a2 + hstep, voffA);
            PG8_WAIT_L(8); PG8_BAR; PG8_WAIT_L(0); PG8_MMA(0, 0, At, B0); PG8_BAR; PG8_SCHED;
            PG8_LDB(B1, 1, 1); PG8_STAGE(PG8_SB(1, 0), b3, voffB);
            PG8_BAR; PG8_WAIT_L(0); PG8_MMA(0, 1, At, B1); PG8_BAR;
            PG8_LDA(At, 1, 1); PG8_STAGE(PG8_SA(1, 0), a3, voffA);
            PG8_BAR; PG8_WAIT_L(0); PG8_MMA(1, 0, At, B0); PG8_BAR; PG8_SCHED;
            PG8_STAGE(PG8_SB(1, 1), b3 + hstepB, voffB);
            PG8_WAIT_V(6); PG8_BAR; PG8_MMA(1, 1, At, B1); PG8_BAR;
            }
        }
        if constexpr (ALIGN_EPI) { if (wr == 0) PG8_BAR; }
        if constexpr (!Epi::AFTER_DRAIN) { int fr_ = fr, fq_ = fq; asm volatile("" : "+v"(fr_), "+v"(fq_));
            E(acc, cur, wr, wc, fr_, fq_, !has_next  ); S.done(cur); }
        if (!has_next) break;
#pragma unroll
        for (int a = 0; a < 2; ++a)
#pragma unroll
            for (int b = 0; b < 2; ++b)
#pragma unroll
                for (int m = 0; m < 4; ++m)
#pragma unroll
                    for (int n = 0; n < 2; ++n) acc[a][b][m][n] = (f32x4){0.f, 0.f, 0.f, 0.f};
        cur = nxt; cA = nA; cB = nB; ++ui;
        if constexpr (ALIGN_EPI) { if (wr == 1) PG8_BAR; }
    }
    PG8_WAIT_V(0);
    if constexpr (!ALIGN_EPI) { if (wr == 0) PG8_BAR; }
    PG8_BAR;
    if constexpr (Epi::AFTER_DRAIN) { E.fused(acc, cur, wr, wc, fr, fq, lds, wid, lane); S.done(cur); }
#undef PG8_SA
#undef PG8_SB
#undef PG8_STAGE
#undef PG8_LDA
#undef PG8_LDB
#undef PG8_MMA
#undef PG8_WAIT_V
#undef PG8_WAIT_L
#undef PG8_BAR
#undef PG8_SCHED
}
}
typedef unsigned short bf16;
typedef float f32x4 __attribute__((ext_vector_type(4)));
typedef unsigned u32x4 __attribute__((ext_vector_type(4)));
constexpr int NB = 2, S = 16384, D = 1024, M = NB * S, INW = 2816, FF = 4096, DEPTH = 2;
constexpr int C_A = 0, C_G = 256, C_RQ = 512, C_RK = 704, C_RV = 896, C_RG = 1280, C_AQ = 1664, C_AK = 2048, C_AV = 2432;
constexpr int MX_CONV = 0, MX_RET = 256, MX_ATT = 640;
constexpr float EPS = 1e-6f;
constexpr size_t MiB = 1u << 20;
constexpr size_t WS_CTL = 0, CTL_BYTES = 1 * MiB;
constexpr size_t WS_W = 2 * MiB;
constexpr size_t W_LAYER = 24641536, W_IN = 0, W_OUT = 5767168, W_F1 = 7864320, W_F2 = 16252928;
constexpr size_t WS_SSQ = 50 * MiB;
constexpr size_t WS_ATAB = 56 * MiB;
constexpr size_t WS_ROPE = 52 * MiB;
constexpr size_t WS_XB = 64 * MiB;
constexpr int HP = FF + 64;
constexpr size_t WS_H = 128 * MiB;
constexpr size_t WS_U = 128 * MiB;
constexpr size_t WS_MIX = 304 * MiB;
constexpr size_t WS_KV = 408 * MiB;
constexpr size_t WS_ST = 420 * MiB;
constexpr size_t WS_END = 432 * MiB;

struct P { const float* in[14]; float* out; unsigned char* ws; };

__device__ __forceinline__ float bf_lo(unsigned w) { return __uint_as_float(w << 16); }
__device__ __forceinline__ float bf_hi(unsigned w) { return __uint_as_float(w & 0xffff0000u); }
__device__ __forceinline__ unsigned f2bf(float f) { unsigned u = __float_as_uint(f); return (u + 0x7fffu + ((u >> 16) & 1u)) >> 16; }
__device__ __forceinline__ unsigned pk2(float lo, float hi) { return f2bf(lo) | (f2bf(hi) << 16); }
__device__ __forceinline__ void unpack8(const u32x4 w, float (&v)[8]) {
    v[0] = bf_lo(w.x); v[1] = bf_hi(w.x); v[2] = bf_lo(w.y); v[3] = bf_hi(w.y); v[4] = bf_lo(w.z); v[5] = bf_hi(w.z); v[6] = bf_lo(w.w); v[7] = bf_hi(w.w); }
__device__ __forceinline__ u32x4 pack8(const float (&v)[8]) { u32x4 w; w.x = pk2(v[0], v[1]); w.y = pk2(v[2], v[3]); w.z = pk2(v[4], v[5]); w.w = pk2(v[6], v[7]); return w; }
__device__ __forceinline__ float wave_sum(float v) {
#pragma unroll
    for (int o = 1; o < 64; o <<= 1) v += __shfl_xor(v, o);
    return v; }
__device__ __forceinline__ int sgpr_opaque(int v) { asm volatile("" : "+s"(v)); return v; }
__device__ __forceinline__ int tid_opaque() { int t = threadIdx.x; asm volatile("" : "+v"(t)); return t; }
__device__ __forceinline__ float gamma_log2(int h) {
    return h == 0 ? -0.04580368961312479f : h == 1 ? -0.02272007650008353f : h == 2 ? -0.011315313227834146f : h == 3 ? -0.005646563141142063f : h == 4 ? -0.0028205190623786626f : -0.0014095702546713536f; }

__device__ __forceinline__ float ssq_to_rstd(const float* ssq, int row) {
    const f32x4* q = (const f32x4*)(ssq + (size_t)row * 16); const f32x4 a = q[0], b = q[1], c = q[2], d = q[3];
    const float s = ((a.x + a.y) + (a.z + a.w)) + ((b.x + b.y) + (b.z + b.w)) + ((c.x + c.y) + (c.z + c.w)) + ((d.x + d.y) + (d.z + d.w));
    return __builtin_amdgcn_rsqf(s * (1.0f / 1024.0f) + EPS); }
template <class Sched> __device__ __forceinline__ void rstd_prepass(const Sched& So, const float* ssq, LAS float* tab) {
    const int tid = tid_opaque(), row = tid >> 1, hf = tid & 1;
    f32x4 a[8], c[8]; unsigned okm = 0u;
#pragma unroll
    for (int i = 0; i < 8; ++i) { pg8::Unit un; const bool ok = So.next(i, un); const int pm = ok ? un.pm : 0; okm |= (ok ? 1u : 0u) << i;
        const f32x4* q = (const f32x4*)(ssq + (size_t)(pm * 256 + row) * 16 + 8 * hf); a[i] = q[0]; c[i] = q[1]; }
#pragma unroll
    for (int i = 0; i < 8; ++i) {
        float s = ((a[i].x + a[i].y) + (a[i].z + a[i].w)) + ((c[i].x + c[i].y) + (c[i].z + c[i].w));
        s += __builtin_bit_cast(float, __builtin_amdgcn_mov_dpp(__builtin_bit_cast(int, s), 0xB1  , 0xf, 0xf, false));
        if (((okm >> i) & 1u) && hf == 0) tab[i * 256 + row] = __builtin_amdgcn_rsqf(s * (1.0f / 1024.0f) + EPS); }
    __syncthreads();
}
__device__ __forceinline__ void st16_wt(void* ptr, u32x4 v) { asm volatile("global_store_dwordx4 %0, %1, off sc0 sc1\n\ts_nop 1" :: "v"(ptr), "v"(v) : "memory"); }
__device__ __forceinline__ void st8_wt(void* ptr, unsigned long long v) { asm volatile("global_store_dwordx2 %0, %1, off sc0 sc1\n\ts_nop 1" :: "v"(ptr), "v"(v) : "memory"); }
__device__ __forceinline__ unsigned dpp_ror8(unsigned x) { return (unsigned)__builtin_amdgcn_mov_dpp((int)x, 0x128  , 0xf, 0xf, false); }
template <bool NT = false> __device__ __forceinline__ void store_rows_full(bf16* grp  , int ld, int fr, int fq, u32x4 d0, u32x4 d1, bool wt) {
    const bool lo = fr < 8; const u32x4 s = lo ? d1 : d0; u32x4 r; r.x = dpp_ror8(s.x); r.y = dpp_ror8(s.y); r.z = dpp_ror8(s.z); r.w = dpp_ror8(s.w);
    const u32x4 a = lo ? d0 : r, c = lo ? r : d1;
    const unsigned loff = (unsigned)(((fr & 7) * ld + (fr >> 3) * 32 + 8 * fq) * 2);
    char* pa = (char*)grp + loff; char* pc = (char*)(grp + (size_t)8 * ld) + loff;
    if (wt) {
        asm volatile("global_store_dwordx4 %0, %1, off sc0 sc1\n\ts_nop 1" :: "v"(pa), "v"(a) : "memory"); asm volatile("global_store_dwordx4 %0, %1, off sc0 sc1\n\ts_nop 1" :: "v"(pc), "v"(c) : "memory"); }
    else if (NT) { __builtin_nontemporal_store(a, (u32x4*)pa); __builtin_nontemporal_store(c, (u32x4*)pc); } else { *(u32x4*)pa = a; *(u32x4*)pc = c; } }
template <int ACT  > struct EpiNormBf16 {
    static constexpr bool PERM = true, AFTER_DRAIN = false;
    bf16* O; const LAS float* rtab; int ldc; mutable int ord;
    __device__ __forceinline__ void operator()(const pg8::f32x4 (&acc)[2][2][4][2], const pg8::Unit& u, int wr, int wc, int fr, int fq, bool wt) const {
        const int row0 = u.pm * 256 + wr * 64 + fr, col0 = u.pn * 256 + wc * 64 + 8 * fq; const LAS float* rt = rtab + ord * 256 + wr * 64 + fr; ++ord;
#pragma unroll
        for (int ai = 0; ai < 2; ++ai)
#pragma unroll
            for (int m = 0; m < 4; ++m) { const float rs = rt[ai * 128 + m * 16]; u32x4 wv[2];
#pragma unroll
                for (int bj = 0; bj < 2; ++bj) { pg8::f32x4 v0 = acc[ai][bj][m][0] * rs, v1 = acc[ai][bj][m][1] * rs;
                    if (ACT == 1) { const pg8::f32x4 z = {0.f, 0.f, 0.f, 0.f}; v0 = __builtin_elementwise_max(v0, z); v1 = __builtin_elementwise_max(v1, z); v0 = v0 * v0; v1 = v1 * v1; }
                    wv[bj].x = pg8::cvt_pk_bf16(v0[0], v0[1]); wv[bj].y = pg8::cvt_pk_bf16(v0[2], v0[3]); wv[bj].z = pg8::cvt_pk_bf16(v1[0], v1[1]); wv[bj].w = pg8::cvt_pk_bf16(v1[2], v1[3]); }
                store_rows_full<ACT == 1>(O + (size_t)(u.pm * 256 + ai * 128 + wr * 64 + m * 16) * ldc + u.pn * 256 + wc * 64, ldc, fr, fq, wv[0], wv[1], wt); }
    }
};
struct EpiInProj {
    static constexpr bool PERM = true, AFTER_DRAIN = false;
    bf16* O; const LAS float* rtab; const float2* rope; const float* qg; const float* kg; mutable int ord;
    __device__ __forceinline__ void operator()(const pg8::f32x4 (&acc)[2][2][4][2], const pg8::Unit& u, int wr, int wc, int fr, int fq, bool wt) const {
        const int colw = u.pn * 256 + wc * 64;
        const LAS float* rt = rtab + ord * 256 + wr * 64 + fr; ++ord;
        const bool att = colw >= C_AQ && colw < C_AV, isk = colw >= C_AK, rot = colw >= C_RQ && colw < C_RV;
        pg8::f32x4 gn[2][2];
#pragma unroll
        for (int bj = 0; bj < 2; ++bj) { const pg8::f32x4* gp = (const pg8::f32x4*)((isk ? kg : qg) + 32 * bj + 8 * fq); gn[bj][0] = gp[0]; gn[bj][1] = gp[1]; }
#pragma unroll
        for (int ai = 0; ai < 2; ++ai) {
            pg8::f32x4 rc[4][2];
            if (rot) {
#pragma unroll
                for (int m = 0; m < 4; ++m) { const int pos = (u.pm * 256 + ai * 128 + wr * 64 + m * 16 + fr) & (S - 1); const pg8::f32x4* rp4 = (const pg8::f32x4*)(rope + pos * 16 + 4 * fq); rc[m][0] = rp4[0]; rc[m][1] = rp4[1]; } }
#pragma unroll
            for (int m = 0; m < 4; ++m) { const int rl = ai * 128 + wr * 64 + m * 16 + fr, row = u.pm * 256 + rl; const float rs = rt[ai * 128 + m * 16];
                pg8::f32x4 v[2][2];
#pragma unroll
                for (int bj = 0; bj < 2; ++bj) { v[bj][0] = acc[ai][bj][m][0] * rs; v[bj][1] = acc[ai][bj][m][1] * rs; }
                if (att) {
                    float q = 0.f;
#pragma unroll
                    for (int bj = 0; bj < 2; ++bj)
#pragma unroll
                        for (int n = 0; n < 2; ++n) q += (v[bj][n][0] * v[bj][n][0] + v[bj][n][1] * v[bj][n][1]) + (v[bj][n][2] * v[bj][n][2] + v[bj][n][3] * v[bj][n][3]);
                    q += __shfl_xor(q, 16); q += __shfl_xor(q, 32);
                    const float r = __builtin_amdgcn_rsqf(q * (1.0f / 64.0f) + EPS) * (isk ? 1.0f : 0.125f);
#pragma unroll
                    for (int bj = 0; bj < 2; ++bj) { v[bj][0] = v[bj][0] * r * gn[bj][0]; v[bj][1] = v[bj][1] * r * gn[bj][1]; }
                } else {
#pragma unroll
                    for (int bj = 0; bj < 2; ++bj) { const int cg = colw + 32 * bj;
                        if (cg >= C_RQ && cg < C_RV) {
                            const bool rk = cg >= C_RK; const int h = ((rk ? cg - C_RK : cg - C_RQ) >> 5);
                            const int pos = row & (S - 1); const float dq = (float)(pos & 127) * gamma_log2(h); const float sc = rk ? 0.17677669529663687f * __builtin_amdgcn_exp2f(-dq) : __builtin_amdgcn_exp2f(dq);
                            const pg8::f32x4 c01 = rc[m][0], c23 = rc[m][1];
                            const pg8::f32x4 a0 = v[bj][0], a1 = v[bj][1];
                            v[bj][0][0] = (a0[0] * c01[0] - a0[1] * c01[1]) * sc; v[bj][0][1] = (a0[0] * c01[1] + a0[1] * c01[0]) * sc; v[bj][0][2] = (a0[2] * c01[2] - a0[3] * c01[3]) * sc; v[bj][0][3] = (a0[2] * c01[3] + a0[3] * c01[2]) * sc;
                            v[bj][1][0] = (a1[0] * c23[0] - a1[1] * c23[1]) * sc; v[bj][1][1] = (a1[0] * c23[1] + a1[1] * c23[0]) * sc; v[bj][1][2] = (a1[2] * c23[2] - a1[3] * c23[3]) * sc; v[bj][1][3] = (a1[2] * c23[3] + a1[3] * c23[2]) * sc; } } }
                u32x4 wv[2];
#pragma unroll
                for (int bj = 0; bj < 2; ++bj) { wv[bj].x = pg8::cvt_pk_bf16(v[bj][0][0], v[bj][0][1]); wv[bj].y = pg8::cvt_pk_bf16(v[bj][0][2], v[bj][0][3]); wv[bj].z = pg8::cvt_pk_bf16(v[bj][1][0], v[bj][1][1]); wv[bj].w = pg8::cvt_pk_bf16(v[bj][1][2], v[bj][1][3]); }
                store_rows_full(O + (size_t)(u.pm * 256 + ai * 128 + wr * 64 + m * 16) * INW + colw, INW, fr, fq, wv[0], wv[1], wt); }
        }
    }
};
struct EpiRes {
    static constexpr bool PERM = true, AFTER_DRAIN = false;
    const float* xf; bf16* xb; float* ssq; float* outf;
    __device__ __forceinline__ void operator()(const pg8::f32x4 (&acc)[2][2][4][2], const pg8::Unit& u, int wr, int wc, int fr, int fq, bool wt) const {
        const int row0 = u.pm * 256 + wr * 64 + fr, col0 = u.pn * 256 + wc * 64 + 8 * fq;
#pragma unroll
        for (int ai2 = 0; ai2 < 4; ++ai2) { const int ai = ai2 >> 1, mb = 2 * (ai2 & 1);
            pg8::f32x4 ra[2][2][2];
            if (xf) {
#pragma unroll
                for (int m = 0; m < 2; ++m)
#pragma unroll
                    for (int bj = 0; bj < 2; ++bj) { const size_t off = (size_t)(row0 + ai * 128 + (mb + m) * 16) * D + col0 + bj * 32;
                        ra[m][bj][0] = __builtin_nontemporal_load((const pg8::f32x4*)(xf + off)); ra[m][bj][1] = __builtin_nontemporal_load((const pg8::f32x4*)(xf + off + 4)); }
            } else {
                u32x4 w[2][2];
#pragma unroll
                for (int m = 0; m < 2; ++m)
#pragma unroll
                    for (int bj = 0; bj < 2; ++bj) w[m][bj] = *(const u32x4*)(xb + (size_t)(row0 + ai * 128 + (mb + m) * 16) * D + col0 + bj * 32);
#pragma unroll
                for (int m = 0; m < 2; ++m)
#pragma unroll
                    for (int bj = 0; bj < 2; ++bj) { const u32x4 t = w[m][bj]; ra[m][bj][0] = (pg8::f32x4){bf_lo(t.x), bf_hi(t.x), bf_lo(t.y), bf_hi(t.y)}; ra[m][bj][1] = (pg8::f32x4){bf_lo(t.z), bf_hi(t.z), bf_lo(t.w), bf_hi(t.w)}; }
            }
#pragma unroll
            for (int m2 = 0; m2 < 2; ++m2) { const int m = mb + m2, row = row0 + ai * 128 + m * 16; float q = 0.f; u32x4 wv[2] = {{0u, 0u, 0u, 0u}, {0u, 0u, 0u, 0u}};
#pragma unroll
                for (int bj = 0; bj < 2; ++bj) { const size_t off = (size_t)row * D + col0 + bj * 32;
                    const pg8::f32x4 v0 = acc[ai][bj][m][0] + ra[m2][bj][0], v1 = acc[ai][bj][m][1] + ra[m2][bj][1];
                    if (outf) { *(pg8::f32x4*)(outf + off) = v0; *(pg8::f32x4*)(outf + off + 4) = v1; }
                    else { q += (v0[0] * v0[0] + v0[1] * v0[1]) + (v0[2] * v0[2] + v0[3] * v0[3]) + (v1[0] * v1[0] + v1[1] * v1[1]) + (v1[2] * v1[2] + v1[3] * v1[3]);
                        wv[bj].x = pg8::cvt_pk_bf16(v0[0], v0[1]); wv[bj].y = pg8::cvt_pk_bf16(v0[2], v0[3]); wv[bj].z = pg8::cvt_pk_bf16(v1[0], v1[1]); wv[bj].w = pg8::cvt_pk_bf16(v1[2], v1[3]); } }
                if (!outf) store_rows_full(xb + (size_t)(u.pm * 256 + ai * 128 + wr * 64 + m * 16) * D + u.pn * 256 + wc * 64, D, fr, fq, wv[0], wv[1], wt);
                if (!outf) { q += __shfl_xor(q, 16); q += __shfl_xor(q, 32);
                    if (fq == 0) ssq[(size_t)row * 16 + u.pn * 4 + wc] = q; } }
        }
    }
};

__device__ __forceinline__ void transpose_item(const float* W, const float* g, int K, int N, bf16* WT, LAS float* scr, int item, int lane) {
    const int nblk = N / 32, kb = item / nblk, nb = item % nblk, k0 = 64 * kb, n0 = 32 * nb;
    f32x4 v[8];
#pragma unroll
    for (int i = 0; i < 8; ++i) v[i] = __builtin_nontemporal_load((const f32x4*)(W + (size_t)(k0 + 8 * i + (lane >> 3)) * N + n0 + 4 * (lane & 7)));
#pragma unroll
    for (int i = 0; i < 8; ++i) { const int kk = 8 * i + (lane >> 3); const float sc = g ? g[k0 + kk] : 1.0f; LAS float* d = scr + kk * 33 + 4 * (lane & 7);
        d[0] = v[i].x * sc; d[1] = v[i].y * sc; d[2] = v[i].z * sc; d[3] = v[i].w * sc; }
    asm volatile("s_waitcnt lgkmcnt(0)" ::: "memory");
    const int c = lane & 7;
#pragma unroll
    for (int j = 0; j < 4; ++j) { const int n = (lane >> 3) + 8 * j; const LAS float* s = scr + (8 * c) * 33 + n;
        u32x4 o; o.x = pk2(s[0 * 33], s[1 * 33]); o.y = pk2(s[2 * 33], s[3 * 33]); o.z = pk2(s[4 * 33], s[5 * 33]); o.w = pk2(s[6 * 33], s[7 * 33]);
        st16_wt(WT + (size_t)(n0 + n) * K + k0 + 8 * c, o); }
    asm volatile("s_waitcnt lgkmcnt(0)" ::: "memory");
}
__device__ __forceinline__ void ph_wconv(const P& p, unsigned char* lds, int bid, int G) {
    const int tid = tid_opaque(), lane = tid & 63, wave = tid >> 6;
    LAS float* scr = (LAS float*)((LAS unsigned char*)lds + wave * 16384);
    const int gw = bid * 8 + wave, NGW = G * 8;
    for (int it = gw; it < 2 * 6016; it += NGW) {
        const int l = it / 6016; int r = it % 6016; unsigned char* wb = p.ws + WS_W + (size_t)l * W_LAYER;
        if (r < 1408) { transpose_item(p.in[2] + (size_t)l * D * INW, p.in[1] + l * D, D, INW, (bf16*)(wb + W_IN), scr, r, lane); continue; } r -= 1408;
        if (r < 512) { transpose_item(p.in[9] + (size_t)l * D * D, nullptr, D, D, (bf16*)(wb + W_OUT), scr, r, lane); continue; } r -= 512;
        if (r < 2048) { transpose_item(p.in[11] + (size_t)l * D * FF, p.in[10] + l * D, D, FF, (bf16*)(wb + W_F1), scr, r, lane); continue; } r -= 2048;
        transpose_item(p.in[12] + (size_t)l * FF * D, nullptr, FF, D, (bf16*)(wb + W_F2), scr, r, lane);
    }
}
__device__ __forceinline__ void ph_xprep(const P& p, int bid, int G) {
    const int tid = tid_opaque(), lane = tid & 63, wave = tid >> 6; const int gw = bid * 8 + wave, NGW = G * 8;
    const float* x = p.in[0]; bf16* xb = (bf16*)(p.ws + WS_XB); float* ssq = (float*)(p.ws + WS_SSQ);
    for (int m0 = 2 * gw; m0 < M; m0 += 2 * NGW) {
        f32x4 v[2][4];
#pragma unroll
        for (int r = 0; r < 2; ++r) { const f32x4* xr = (const f32x4*)(x + (size_t)(m0 + r) * D) + lane;
#pragma unroll
            for (int j = 0; j < 4; ++j) v[r][j] = __builtin_nontemporal_load(xr + 64 * j); }
#pragma unroll
        for (int r = 0; r < 2; ++r) { const int m = m0 + r; float s = 0.f;
#pragma unroll
            for (int j = 0; j < 4; ++j) s += (v[r][j].x * v[r][j].x + v[r][j].y * v[r][j].y) + (v[r][j].z * v[r][j].z + v[r][j].w * v[r][j].w);
            s = wave_sum(s);
            unsigned long long* o8 = (unsigned long long*)(xb + (size_t)m * D) + lane;
#pragma unroll
            for (int j = 0; j < 4; ++j) st8_wt(o8 + 64 * j, (unsigned long long)pk2(v[r][j].x, v[r][j].y) | ((unsigned long long)pk2(v[r][j].z, v[r][j].w) << 32));
            if (lane < 16) ssq[(size_t)m * 16 + lane] = lane == 0 ? s : 0.f; }
    }
    float2* rope = (float2*)(p.ws + WS_ROPE);
    for (int i = bid * 512 + tid; i < S * 16; i += G * 512) { const int pos = i >> 4, k = i & 15;
        const float e = (float)k / 15.0f; const float inv = 1.0f / powf(10000.0f, e); const float ang = (float)pos * inv;
        rope[i] = make_float2((float)cos((double)ang), (float)sin((double)ang)); }
}
__device__ __forceinline__ float wave_sum_dpp(float v) {
    v += __builtin_bit_cast(float, __builtin_amdgcn_update_dpp(0, __builtin_bit_cast(int, v), 0xB1, 0xf, 0xf, false));
    v += __builtin_bit_cast(float, __builtin_amdgcn_update_dpp(0, __builtin_bit_cast(int, v), 0x4E, 0xf, 0xf, false));
    v += __builtin_bit_cast(float, __builtin_amdgcn_update_dpp(0, __builtin_bit_cast(int, v), 0x141, 0xf, 0xf, false));
    v += __builtin_bit_cast(float, __builtin_amdgcn_update_dpp(0, __builtin_bit_cast(int, v), 0x140, 0xf, 0xf, false));
    const int iv = __builtin_bit_cast(int, v);
    return (__builtin_bit_cast(float, __builtin_amdgcn_readlane(iv, 0)) + __builtin_bit_cast(float, __builtin_amdgcn_readlane(iv, 16))) + (__builtin_bit_cast(float, __builtin_amdgcn_readlane(iv, 32)) + __builtin_bit_cast(float, __builtin_amdgcn_readlane(iv, 48)));
}
__device__ __forceinline__ void ph_conv(const P& p, int layer, unsigned char* lds, int bid, int G, int early  ) {
    const int tid = tid_opaque(); const bf16* u = (const bf16*)(p.ws + WS_U); bf16* mix = (bf16*)(p.ws + WS_MIX);
    float* hl = (float*)lds;
    const int c = tid & 255, half = tid >> 8;
    float W[31];
#pragma unroll
    for (int w = 0; w < 31; ++w) W[w] = p.in[3][(size_t)layer * 31 * 256 + w * 256 + c];
    const float bias = p.in[4][layer * 256 + c], gain = p.in[5][layer * 256 + c];
    int cu0 = bid, cn = early ? 0 : (M / 64 - bid + G - 1) / G, cst = G;
    if (G == 256) { cst = 1;
        if (early) { cu0 = 256 + 2 * (bid - 128); cn = bid >= 128 ? 2 : 0; }
        else { if (bid >= 192) { cu0 = 3 * (bid - 192); cn = 3; } else if (bid >= 128) { cu0 = 192 + (bid - 128); cn = 1; } else cn = 0; } }
    for (int ck = 0; ck < cn; ++ck) { const int unit = cu0 + ck * cst;
        const int b = unit / (S / 64), t0 = (unit % (S / 64)) * 64;
        const bf16* ubase = u + (size_t)b * S * INW;
        u32x4 ra[6], rg[6];
#pragma unroll
        for (int k = 0; k < 6; ++k) { const int task = min(tid + 512 * k, 94 * 32 - 1), r = task >> 5, c8 = (task & 31) * 8; const int tok = max(t0 - 30 + r, 0);
            const bf16* up = ubase + (size_t)tok * INW + c8; ra[k] = *(const u32x4*)(up + C_A); rg[k] = *(const u32x4*)(up + C_G); }
#pragma unroll
        for (int k = 0; k < 6; ++k) { const int task = min(tid + 512 * k, 94 * 32 - 1), r = task >> 5, c8 = (task & 31) * 8; const float keep = (t0 - 30 + r) >= 0 ? 1.0f : 0.0f;
            float a[8], g[8], h[8]; unpack8(ra[k], a); unpack8(rg[k], g);
#pragma unroll
            for (int t = 0; t < 8; ++t) h[t] = keep * a[t] * __builtin_amdgcn_rcpf(1.0f + __expf(-g[t]));
            *(f32x4*)(hl + r * 256 + c8) = (f32x4){h[0], h[1], h[2], h[3]}; *(f32x4*)(hl + r * 256 + c8 + 4) = (f32x4){h[4], h[5], h[6], h[7]}; }
        __syncthreads();
#pragma unroll 1
        for (int run = 0; run < 2; ++run) {
            const int tb = half * 32 + run * 16;
            float win[46];
#pragma unroll
            for (int i = 0; i < 46; ++i) win[i] = hl[(tb + i) * 256 + c];
#pragma unroll
            for (int tt = 0; tt < 16; ++tt) { float acc = bias;
#pragma unroll
                for (int w = 0; w < 31; ++w) acc = fmaf(W[w], win[tt + w], acc);
                const float ss = wave_sum_dpp(acc * acc); float y = acc * __builtin_amdgcn_rsqf(ss * (1.0f / 64.0f) + EPS) * gain; y = y * __builtin_amdgcn_rcpf(1.0f + __expf(-y));
                mix[(size_t)(b * S + t0 + tb + tt) * D + MX_CONV + c] = (bf16)f2bf(y); }
        }
        __syncthreads();
    }
}
typedef short bf16x8_t __attribute__((ext_vector_type(8)));
typedef float f32x16 __attribute__((ext_vector_type(16)));
typedef short s16x4_t __attribute__((ext_vector_type(4)));
constexpr int A2_TAB = 1376, A2_T1 = 0, A2_T4 = 192, A2_T1A = 576;
constexpr int A2_LDS_V = 33792, A2_LDS_K = A2_LDS_V + 8 * 4096, A2_LDS_OX = A2_LDS_K + 8 * 4096, A2_LDS_LX = A2_LDS_OX + 256 * 64 * 2;
constexpr float LOG2E = 1.4426950408889634f;
__device__ __forceinline__ unsigned cvtpk(float lo, float hi) { typedef float f2 __attribute__((ext_vector_type(2))); typedef __bf16 b2 __attribute__((ext_vector_type(2))); f2 v = {lo, hi}; b2 b = __builtin_convertvector(v, b2); return __builtin_bit_cast(unsigned, b); }
__device__ __forceinline__ void at2_compute(const LAS unsigned char* krd, int ksel, const bf16x8_t (&qf)[4], const float* tp_, int kneg, int hh, unsigned char* vs, int vroff, int tsw, f32x16& o0, f32x16& o1, f32x16& lacc) {
    f32x16 s;
#pragma unroll
    for (int i = 0; i < 16; ++i) s[i] = 0.f;
#pragma unroll
    for (int t = 0; t < 4; ++t) s = __builtin_amdgcn_mfma_f32_32x32x16_bf16(*(const LAS bf16x8_t*)(krd + (((2 * t) ^ ksel) * 16)), qf[t], s, 0, 0, 0);
    float pe[16];
#pragma unroll
    for (int i = 0; i < 16; ++i) pe[i] = __builtin_amdgcn_exp2f(fmaf(s[i], LOG2E, tp_[(i & 3) + 8 * (i >> 2)]));
    if (kneg > 0) {
        asm volatile("" ::: "memory");
#pragma unroll
        for (int i = 0; i < 16; ++i) if ((i & 3) + 8 * (i >> 2) + 4 * hh < kneg) pe[i] = 0.f; }
    bf16x8_t pf[2];
#pragma unroll
    for (int sx = 0; sx < 2; ++sx) { u32x4 w; w.x = cvtpk(pe[8 * sx + 0], pe[8 * sx + 1]); w.y = cvtpk(pe[8 * sx + 2], pe[8 * sx + 3]); w.z = cvtpk(pe[8 * sx + 4], pe[8 * sx + 5]); w.w = cvtpk(pe[8 * sx + 6], pe[8 * sx + 7]); pf[sx] = __builtin_bit_cast(bf16x8_t, w); }
    const bf16x8_t ones = (bf16x8_t){0x3F80, 0x3F80, 0x3F80, 0x3F80, 0x3F80, 0x3F80, 0x3F80, 0x3F80};
#pragma unroll
    for (int sx = 0; sx < 2; ++sx) {
        lacc = __builtin_amdgcn_mfma_f32_32x32x16_bf16(pf[sx], ones, lacc, 0, 0, 0);
#pragma unroll
        for (int db = 0; db < 2; ++db) {
            const LAS unsigned char* va = (const LAS unsigned char*)vs + vroff + sx * 2048 + ((db ^ tsw) * 64);
            const s16x4_t lo = __builtin_bit_cast(s16x4_t, __builtin_amdgcn_ds_read_tr16_b64_v4i16((LAS s16x4_t*)va));
            const s16x4_t hi = __builtin_bit_cast(s16x4_t, __builtin_amdgcn_ds_read_tr16_b64_v4i16((LAS s16x4_t*)(va + 1024)));
            const bf16x8_t vf = (bf16x8_t){lo[0], lo[1], lo[2], lo[3], hi[0], hi[1], hi[2], hi[3]};
            if (db == 0) o0 = __builtin_amdgcn_mfma_f32_32x32x16_bf16(pf[sx], vf, o0, 0, 0, 0); else o1 = __builtin_amdgcn_mfma_f32_32x32x16_bf16(pf[sx], vf, o1, 0, 0, 0); } }
}
__device__ __forceinline__ void ph_attn_tables(const P& p, int bid, int G) {
    const int tid = tid_opaque(); const float* rb = p.in[13]; float* out = (float*)(p.ws + WS_ATAB);
    const int total = DEPTH * 6 * A2_TAB;
    for (int e0 = bid * 512; e0 < total; e0 += G * 512) {
        const int e = e0 + tid; if (e >= total) continue;
        const int l = e / (6 * A2_TAB), r = e % (6 * A2_TAB), hd = r / A2_TAB, x = r % A2_TAB;
        const float* qg = p.in[7] + l * 64; const float* kg = p.in[8] + l * 64;
        float mq = 0.f, mk = 0.f, mb = 0.f;
        for (int c = 0; c < 64; ++c) { mq = fmaxf(mq, fabsf(qg[c])); mk = fmaxf(mk, fabsf(kg[c])); }
        for (int c = 0; c < 192; ++c) mb = fmaxf(mb, rb[c]);
        const float cshift = 8.0f * mq * mk + mb;
        int dl, dist;
        if (x < A2_T4) { dl = 16; dist = 128 - (x - 31); } else if (x < A2_T1A) { dl = 4; dist = 128 - (x - A2_T4 - 124); } else { const int z = x - A2_T1A; dl = 1; dist = 128 + 16 * (z / 200) - (z % 200 - 7); }
        float v = -1e30f;
        if (dist >= 0 && dist <= 128) { const int n = dist * dl; int bucket;
            if (n < 16) bucket = n; else { const float nf = (float)n; const int lg = 16 + (int)(logf(nf / 16.0f) / 4.852030263919617f * 16.0f); bucket = lg < 31 ? lg : 31; }
            v = (rb[bucket * 6 + hd] - cshift) * LOG2E; }
        out[e] = v; }
}
__device__ __forceinline__ void ph_attn(const P& p, int layer, unsigned char* lds, int bid, int G) {
    const int tid = tid_opaque(), lane = tid & 63, wave = __builtin_amdgcn_readfirstlane(tid >> 6);
    float* tab = (float*)lds;
    {   const f32x4* src = (const f32x4*)(p.ws + WS_ATAB) + (size_t)layer * (6 * A2_TAB / 4);
        constexpr int NV = 6 * A2_TAB / 4, NI = (NV + 511) / 512; f32x4 tv[NI];
#pragma unroll
        for (int i = 0; i < NI; ++i) tv[i] = src[min(tid + 512 * i, NV - 1)];
#pragma unroll
        for (int i = 0; i < NI; ++i) if (tid + 512 * i < NV) ((f32x4*)tab)[tid + 512 * i] = tv[i]; }
    __syncthreads();
    const bf16* u = (const bf16*)(p.ws + WS_U); bf16* mix = (bf16*)(p.ws + WS_MIX);
    unsigned char* vs = lds + A2_LDS_V + wave * 4096; unsigned char* ksw = lds + A2_LDS_K + wave * 4096; bf16* Ox = (bf16*)(lds + A2_LDS_OX); float* lx = (float*)(lds + A2_LDS_LX);
    const int r32 = lane & 31, hh = lane >> 5;
    const int vrow = lane >> 3, vch = lane & 7;
    const int vwoff = vrow * 128 + ((vch ^ (((vrow >> 1) & 1) << 2)) * 16);
    const int tq = (lane & 15) >> 2, tp = lane & 3, tsw = (tq >> 1) & 1;
    const int vroff = (4 * hh + tq) * 128 + (2 * ((lane >> 4) & 1) + (tp >> 1)) * 16 + (tp & 1) * 8;
    const int kwoff = vrow * 128 + ((vch ^ vrow) * 16);
    const int ksel = hh ^ (r32 & 7);
    const LAS unsigned char* krd = (const LAS unsigned char*)ksw + r32 * 128;
#define A2_UNIT(BU, HALF, SP, HD, B) do { if (G == 256) { const int xcd_ = bid & 7, slot_ = bid >> 3, k_ = (BU) >> 8, bh_ = 4 * k_ + (xcd_ >> 1); HALF = slot_ & 1; SP = 16 * (xcd_ & 1) + (slot_ >> 1); HD = bh_ % 6; B = bh_ / 6; } \
        else { HALF = (BU) & 1; SP = ((BU) >> 1) & 31; HD = ((BU) >> 6) % 6; B = (BU) / 384; } } while (0)
    const int rot = (4 * wave) % 6;
#define A2_KT(T) (((T) + rot) % 6)
#define A2_PREF_A(UBN, BASEN) do { const int pkb_ = (BASEN) - 128 + 32 * A2_KT(0); \
        _Pragma("unroll") for (int it_ = 0; it_ < 4; ++it_) kA[it_] = *(const u32x4*)((const char*)(UBN) + (unsigned)(min(max(pkb_ + vrow + 8 * it_, 0), S - 1) * (INW * 2) + (C_AK + 8 * vch) * 2)); \
        _Pragma("unroll") for (int it_ = 0; it_ < 4; ++it_) vA[it_] = *(const u32x4*)((const char*)(UBN) + (unsigned)(min(max(pkb_ + vrow + 8 * it_, 0), S - 1) * (INW * 2) + (C_AV + 8 * vch) * 2)); \
        { const bf16* qp_ = (UBN) + (size_t)((BASEN) + 16 * (r32 >> 3) + (r32 & 7)) * INW + C_AQ + 8 * hh; \
          _Pragma("unroll") for (int t_ = 0; t_ < 4; ++t_) qfa[t_] = *(const bf16x8_t*)(qp_ + 16 * t_); } } while (0)
    u32x4 kA[4], kB[4], vA[4], vB[4];
    bf16x8_t qfa[4], qfb[4];
    int half = 0, sp = 0, hd = 0, b = 0;
    if (bid < 768) { A2_UNIT(bid, half, sp, hd, b); A2_PREF_A(u + (size_t)b * S * INW + hd * 64, sp * 512 + 64 * wave + 8 * half); }
    for (int bu = bid; bu < 768; bu += G) {
        const int p0 = sp * 512, rr0 = 8 * half;
        const bf16* ub = u + (size_t)b * S * INW + hd * 64;
        const float* tbh = tab + hd * A2_TAB;
        f32x16 o0, o1, lacc;
#pragma unroll
        for (int i = 0; i < 16; ++i) { o0[i] = 0.f; o1[i] = 0.f; lacc[i] = 0.f; }
        const int rr = rr0 + wave;
        const int k1 = max(0, 4 - p0 / 512), k4b = max(0, 4 - p0 / 128), k4 = k4b - ((k4b > 0 && rr >= 4) ? 1 : 0);
        const int n1 = 5 - k1, NT = n1 + 8 - k4;
        int d_pkb, d_tb, d_kneg, d_dls;
        { const int t = min(lane, NT - 1);
          if (t < n1) { const int kt = k1 + t; d_dls = 4; d_pkb = p0 + rr - 2048 + 512 * kt; d_tb = A2_T1 + 31 + 32 * kt; }
          else { const int kt = k4 + t - n1; d_dls = 2; d_pkb = p0 + rr - 512 + 128 * kt; d_tb = A2_T4 + 124 + 32 * kt; }
          d_kneg = lane >= NT ? 32 : (d_pkb < 0 ? ((-d_pkb + (1 << d_dls) - 1) >> d_dls) : 0); }
#define A2_ISSUE_B(F, KR, VR) do { const int pkb_ = __builtin_amdgcn_readlane(d_pkb, (F)), dls_ = __builtin_amdgcn_readlane(d_dls, (F)); \
                _Pragma("unroll") for (int it_ = 0; it_ < 4; ++it_) KR[it_] = *(const u32x4*)((const char*)ub + (unsigned)(min(max(pkb_ + ((vrow + 8 * it_) << dls_), 0), S - 1) * (INW * 2) + (C_AK + 8 * vch) * 2)); \
                _Pragma("unroll") for (int it_ = 0; it_ < 4; ++it_) VR[it_] = *(const u32x4*)((const char*)ub + (unsigned)(min(max(pkb_ + ((vrow + 8 * it_) << dls_), 0), S - 1) * (INW * 2) + (C_AV + 8 * vch) * 2)); } while (0)
        {   const int base = p0 + 64 * wave + rr0;
            const float* tpa = tbh + A2_T1A + (r32 >> 3) * 200 + 7 - (r32 & 7) + 4 * hh;
#define A2_ISSUE_A(T, KR, VR) do { const int pkb_ = base - 128 + 32 * A2_KT(T); \
                _Pragma("unroll") for (int it_ = 0; it_ < 4; ++it_) KR[it_] = *(const u32x4*)((const char*)ub + (unsigned)(min(max(pkb_ + vrow + 8 * it_, 0), S - 1) * (INW * 2) + (C_AK + 8 * vch) * 2)); \
                _Pragma("unroll") for (int it_ = 0; it_ < 4; ++it_) VR[it_] = *(const u32x4*)((const char*)ub + (unsigned)(min(max(pkb_ + vrow + 8 * it_, 0), S - 1) * (INW * 2) + (C_AV + 8 * vch) * 2)); } while (0)
#define A2_STEP_A(T, KR, VR, KN, VN) do { \
                _Pragma("unroll") for (int it_ = 0; it_ < 4; ++it_) { *(u32x4*)(vs + vwoff + it_ * 1024) = VR[it_]; *(u32x4*)(ksw + kwoff + it_ * 1024) = KR[it_]; } \
                A2_ISSUE_A((T) + 1, KN, VN); \
                { const int kt_ = A2_KT(T), pkb_ = base - 128 + 32 * kt_; const int kneg_ = min(max(0, -pkb_), 32); \
                  at2_compute(krd, ksel, qfa, tpa + 32 * kt_, kneg_, hh, vs, vroff, tsw, o0, o1, lacc); } } while (0)
#pragma unroll 1
            for (int t = 0; t < 4; t += 2) { A2_STEP_A(t, kA, vA, kB, vB); A2_STEP_A(t + 1, kB, vB, kA, vA); }
            A2_STEP_A(4, kA, vA, kB, vB);
            { _Pragma("unroll") for (int it_ = 0; it_ < 4; ++it_) { *(u32x4*)(vs + vwoff + it_ * 1024) = vB[it_]; *(u32x4*)(ksw + kwoff + it_ * 1024) = kB[it_]; }
              A2_ISSUE_B(0, kA, vA);
              { const bf16* qp = ub + (size_t)(p0 + rr + 16 * r32) * INW + C_AQ + 8 * hh;
                _Pragma("unroll") for (int t = 0; t < 4; ++t) qfb[t] = *(const bf16x8_t*)(qp + 16 * t); }
              const int kt_ = A2_KT(5), pkb_ = base - 128 + 32 * kt_; at2_compute(krd, ksel, qfa, tpa + 32 * kt_, min(max(0, -pkb_), 32), hh, vs, vroff, tsw, o0, o1, lacc); }
#undef A2_ISSUE_A
#undef A2_STEP_A
            bf16* oxw = Ox + (32 * wave + 4 * hh) * 64 + r32; float* lxw = lx + 32 * wave + 4 * hh;
#pragma unroll
            for (int i = 0; i < 16; ++i) { const int ci = (i & 3) + 8 * (i >> 2); oxw[ci * 64] = (bf16)f2bf(o0[i]); oxw[ci * 64 + 32] = (bf16)f2bf(o1[i]); if (r32 == 0) lxw[ci] = lacc[i]; }
        }
        __syncthreads();
        int half_n, sp_n, hd_n, b_n;
        {   const bf16* oxr = Ox + (32 * hh + wave) * 64 + r32; const float* lxr = lx + 32 * hh + wave;
#pragma unroll
            for (int i = 0; i < 16; ++i) { const int ci = 8 * ((i & 3) + 8 * (i >> 2)); o0[i] = bf_lo((unsigned)oxr[ci * 64]); o1[i] = bf_lo((unsigned)oxr[ci * 64 + 32]); lacc[i] = lxr[ci]; }
#define A2_STEP_B(F, KR, VR, KN, VN) do { \
                _Pragma("unroll") for (int it_ = 0; it_ < 4; ++it_) { *(u32x4*)(vs + vwoff + it_ * 1024) = VR[it_]; *(u32x4*)(ksw + kwoff + it_ * 1024) = KR[it_]; } \
                A2_ISSUE_B((F) + 1, KN, VN); \
                { const int tb_ = __builtin_amdgcn_readlane(d_tb, (F)), kneg_ = __builtin_amdgcn_readlane(d_kneg, (F)), dls_ = __builtin_amdgcn_readlane(d_dls, (F)); \
                  at2_compute(krd, ksel, qfb, tbh + tb_ - (r32 << (4 - dls_)) + 4 * hh, kneg_, hh, vs, vroff, tsw, o0, o1, lacc); } } while (0)
            int f = 0;
            for (; f + 1 < NT; f += 2) { A2_STEP_B(f, kA, vA, kB, vB); A2_STEP_B(f + 1, kB, vB, kA, vA); }
            const bool odd = f < NT;
            if (odd) { _Pragma("unroll") for (int it_ = 0; it_ < 4; ++it_) { *(u32x4*)(vs + vwoff + it_ * 1024) = vA[it_]; *(u32x4*)(ksw + kwoff + it_ * 1024) = kA[it_]; } }
            { const int bn = bu + G < 768 ? bu + G : bu; A2_UNIT(bn, half_n, sp_n, hd_n, b_n);
              A2_PREF_A(u + (size_t)b_n * S * INW + hd_n * 64, sp_n * 512 + 64 * wave + 8 * half_n); }
            if (odd) {
                const int tb_ = __builtin_amdgcn_readlane(d_tb, f), kneg_ = __builtin_amdgcn_readlane(d_kneg, f), dls_ = __builtin_amdgcn_readlane(d_dls, f);
                at2_compute(krd, ksel, qfb, tbh + tb_ - (r32 << (4 - dls_)) + 4 * hh, kneg_, hh, vs, vroff, tsw, o0, o1, lacc); }
#undef A2_STEP_B
            bf16* ot = (bf16*)ksw;
#pragma unroll
            for (int i = 0; i < 16; ++i) { const int qi = (i & 3) + 8 * (i >> 2) + 4 * hh; const float il = __builtin_amdgcn_rcpf(lacc[i]);
                ot[qi * 64 + r32] = (bf16)f2bf(o0[i] * il); ot[qi * 64 + 32 + r32] = (bf16)f2bf(o1[i] * il); }
            { const int orow = lane >> 1, oh = lane & 1; const u32x4* os = (const u32x4*)(ot + orow * 64 + 32 * oh);
              u32x4* og = (u32x4*)(mix + ((size_t)b * S + p0 + rr + 16 * orow) * D + MX_ATT + hd * 64 + 32 * oh);
#pragma unroll
              for (int k = 0; k < 4; ++k) og[k] = os[k]; }
        }
#undef A2_ISSUE_B
        __syncthreads();
        half = half_n; sp = sp_n; hd = hd_n; b = b_n;
    }
#undef A2_PREF_A
#undef A2_KT
#undef A2_UNIT
    __syncthreads();
}
__device__ __forceinline__ bf16x8_t tr2(const LAS unsigned char* a, int second) {
    const s16x4_t lo = __builtin_bit_cast(s16x4_t, __builtin_amdgcn_ds_read_tr16_b64_v4i16((LAS s16x4_t*)a));
    const s16x4_t hi = __builtin_bit_cast(s16x4_t, __builtin_amdgcn_ds_read_tr16_b64_v4i16((LAS s16x4_t*)(a + second)));
    return (bf16x8_t){lo[0], lo[1], lo[2], lo[3], hi[0], hi[1], hi[2], hi[3]}; }
__device__ __forceinline__ void ph_retI(const P& p, unsigned char* lds, int bid_, int G) {
    const int bid = sgpr_opaque(bid_);
    const int tid = tid_opaque(), lane = tid & 63, wave = __builtin_amdgcn_readfirstlane(tid >> 6), r32 = lane & 31, hh = lane >> 5;
    const bf16* u = (const bf16*)(p.ws + WS_U); float* Pb = (float*)(p.ws + WS_KV); float* Xb = (float*)(p.ws + WS_ST);
    unsigned char* ks = lds + wave * 16384; unsigned char* vs = ks + 8192;
    const int troff = (8 * hh + ((lane & 15) >> 2)) * 64 + (16 * ((lane >> 4) & 1) + 4 * (lane & 3)) * 2;
    for (int unit = bid; unit < 384; unit += G) {
        int db, run, bh;
        if (G == 256) { const int x = bid & 7, j = (unit >> 8) * 32 + (bid >> 3), grp = x * 12 + (j >> 2), bhp = grp >> 4; db = j & 1; run = grp & 15; bh = (bhp / 3) * 6 + 2 * (bhp % 3) + ((j >> 1) & 1); }
        else { db = unit & 1; run = (unit >> 1) & 15; bh = unit >> 5; }
        const int b = bh / 6, h = bh % 6, n = run * 8 + wave;
        const float g128 = exp2f(128.0f * gamma_log2(h));
        const bf16* ukb = u + ((size_t)b * S + n * 128) * INW + C_RK + h * 32; const bf16* uvb = u + ((size_t)b * S + n * 128) * INW + C_RV + h * 64 + db * 32;
        u32x4 kr[8], vr[8];
#pragma unroll
        for (int it = 0; it < 8; ++it) { const int c = lane + 64 * it, row = c >> 2, ch = c & 3; kr[it] = *(const u32x4*)(ukb + (size_t)row * INW + ch * 8); vr[it] = *(const u32x4*)(uvb + (size_t)row * INW + ch * 8); }
#pragma unroll
        for (int it = 0; it < 8; ++it) { const int c = lane + 64 * it; *(u32x4*)(ks + c * 16) = kr[it]; *(u32x4*)(vs + c * 16) = vr[it]; }
        f32x16 dW;
#pragma unroll
        for (int i = 0; i < 16; ++i) dW[i] = 0.f;
#pragma unroll
        for (int s = 0; s < 8; ++s) { const bf16x8_t af = tr2((const LAS unsigned char*)ks + troff + s * 1024, 256), bfv = tr2((const LAS unsigned char*)vs + troff + s * 1024, 256);
            dW = __builtin_amdgcn_mfma_f32_32x32x16_bf16(af, bfv, dW, 0, 0, 0); }
        float* xw = (float*)ks;
#pragma unroll
        for (int i = 0; i < 16; ++i) xw[i * 64 + lane] = dW[i];
        __syncthreads();
        f32x16 X;
#pragma unroll
        for (int i = 0; i < 16; ++i) X[i] = 0.f;
        float cf = g128;
        for (int j = wave - 1; j >= 0; --j) { const float* xr = (const float*)(lds + j * 16384);
#pragma unroll
            for (int i = 0; i < 16; ++i) X[i] += cf * xr[i * 64 + lane];
            cf *= g128; }
        { float* Pp = Pb + ((size_t)(bh * 128 + n) * 64 + db * 32 + r32) * 32 + 4 * hh;
#pragma unroll
          for (int g = 0; g < 4; ++g) *(f32x4*)(Pp + 8 * g) = (f32x4){X[4 * g], X[4 * g + 1], X[4 * g + 2], X[4 * g + 3]}; }
        if (wave == 7) {
            float* Xp = Xb + ((size_t)(bh * 16 + run) * 64 + db * 32 + r32) * 32 + 4 * hh;
#pragma unroll
            for (int g = 0; g < 4; ++g) *(f32x4*)(Xp + 8 * g) = (f32x4){g128 * (X[4 * g] + dW[4 * g]), g128 * (X[4 * g + 1] + dW[4 * g + 1]), g128 * (X[4 * g + 2] + dW[4 * g + 2]), g128 * (X[4 * g + 3] + dW[4 * g + 3])}; }
        __syncthreads();
    }
    __syncthreads();
}
constexpr int R2_WST = 0, R2_WAVE = 8192, R2_WSTRIDE = 16384;
__device__ __forceinline__ void ph_retII(const P& p, int layer, unsigned char* lds, int bid, int G) {
    const int tid = tid_opaque(), lane = tid & 63, wave = __builtin_amdgcn_readfirstlane(tid >> 6), r32 = lane & 31, hh = lane >> 5;
    const bf16* u = (const bf16*)(p.ws + WS_U); bf16* mix = (bf16*)(p.ws + WS_MIX); const float* Pb = (const float*)(p.ws + WS_KV); const float* Xb = (const float*)(p.ws + WS_ST);
    const float* retg = p.in[6] + layer * 384;
    float* wst = (float*)(lds + R2_WST);
    unsigned char* vs = lds + R2_WAVE + wave * R2_WSTRIDE;
    const int vrow = lane >> 3, vch = lane & 7, vwoff = vrow * 128 + ((vch ^ (((vrow >> 1) & 1) << 2)) * 16);
    const int tq = (lane & 15) >> 2, tp = lane & 3, tsw = (tq >> 1) & 1;
    const int vroff = (4 * hh + tq) * 128 + (2 * ((lane >> 4) & 1) + (tp >> 1)) * 16 + (tp & 1) * 8;
    const int erow = lane >> 1, eh16 = lane & 1;
    for (int bu = bid; bu < 192; bu += G) {
        int bh, run;
        if (G == 256) { const int x = bid & 7, slot = bid >> 3, grp = x * 12 + (slot >> 1), bhp = grp >> 4; run = grp & 15; bh = (bhp / 3) * 6 + 2 * (bhp % 3) + (slot & 1); }
        else { bh = bu >> 4; run = bu & 15; }
        const int b = bh / 6, h = bh % 6, n = run * 8 + wave; const size_t row0 = (size_t)b * S + n * 128; const float l2g = gamma_log2(h);
        const bf16* ub = u + row0 * INW;
        u32x4 vr[16];
#pragma unroll
        for (int it = 0; it < 16; ++it) { const int c = lane + 64 * it; vr[it] = __builtin_nontemporal_load((const u32x4*)(ub + (size_t)(c >> 3) * INW + C_RV + h * 64 + (c & 7) * 8)); }
        bf16x8_t qn[2], kf[4][2];
#pragma unroll
        for (int q = 0; q < 4; ++q) { const bf16* rp = ub + (size_t)(32 * q + r32) * INW + h * 32 + 8 * hh; kf[q][0] = *(const bf16x8_t*)(rp + C_RK); kf[q][1] = *(const bf16x8_t*)(rp + C_RK + 16); }
        { const bf16* rp = ub + (size_t)r32 * INW + h * 32 + 8 * hh + C_RQ; qn[0] = *(const bf16x8_t*)rp; qn[1] = *(const bf16x8_t*)(rp + 16); }
        f32x4 pr[2][2][2];
        { const float* Pp = Pb + ((size_t)(bh * 128 + n) * 64 + r32) * 32 + 8 * hh;
#pragma unroll
          for (int db = 0; db < 2; ++db)
#pragma unroll
              for (int s = 0; s < 2; ++s) { pr[db][s][0] = *(const f32x4*)(Pp + db * 1024 + 16 * s); pr[db][s][1] = *(const f32x4*)(Pp + db * 1024 + 16 * s + 4); } }
        { const int dim = 8 * wave + (lane >> 3), dk4 = (lane & 7) * 4; f32x4 xr[15];
#pragma unroll
          for (int j = 0; j < 15; ++j) { const int m = max(run - 1 - j, 0); xr[j] = *(const f32x4*)(Xb + ((size_t)(bh * 16 + m) * 64 + dim) * 32 + dk4); }
          f32x4 acc = {0.f, 0.f, 0.f, 0.f}; float cf = 1.0f; const float c1024 = exp2f(1024.0f * l2g);
#pragma unroll
          for (int j = 0; j < 15; ++j) { const float cc = j < run ? cf : 0.0f; acc += cc * xr[j]; cf *= c1024; }
          *(f32x4*)(wst + dim * 32 + dk4) = acc; }
        __syncthreads();
        bf16x8_t wf[2][2];
        { const float g128t = exp2f(128.0f * (float)wave * l2g);
#pragma unroll
          for (int db = 0; db < 2; ++db)
#pragma unroll
              for (int s = 0; s < 2; ++s) { const float* wp = wst + (32 * db + r32) * 32 + 16 * s + 8 * hh; const f32x4 a = pr[db][s][0] + g128t * *(const f32x4*)wp, c4 = pr[db][s][1] + g128t * *(const f32x4*)(wp + 4);
                  u32x4 pk; pk.x = cvtpk(a.x, a.y); pk.y = cvtpk(a.z, a.w); pk.z = cvtpk(c4.x, c4.y); pk.w = cvtpk(c4.z, c4.w); wf[db][s] = __builtin_bit_cast(bf16x8_t, pk); } }
#pragma unroll
        for (int it = 0; it < 12; ++it) *(u32x4*)(vs + (it >> 2) * 4096 + vwoff + (it & 3) * 1024) = vr[it];
#pragma unroll 1
        for (int qt = 0; qt < 4; ++qt) {
            bf16x8_t qc[2]; qc[0] = qn[0]; qc[1] = qn[1];
            { const bf16* rp = ub + (size_t)(32 * min(qt + 1, 3) + r32) * INW + h * 32 + 8 * hh + C_RQ; qn[0] = *(const bf16x8_t*)rp; qn[1] = *(const bf16x8_t*)(rp + 16); }
            const bf16* gp = ub + (size_t)(32 * qt + erow) * INW + C_RG + h * 64 + 16 * eh16; u32x4 gv[4];
            gv[0] = __builtin_nontemporal_load((const u32x4*)gp); gv[1] = __builtin_nontemporal_load((const u32x4*)(gp + 8)); gv[2] = __builtin_nontemporal_load((const u32x4*)(gp + 32)); gv[3] = __builtin_nontemporal_load((const u32x4*)(gp + 40));
            if (qt == 3) {
#pragma unroll
                for (int it = 0; it < 4; ++it) *(u32x4*)(vs + 3 * 4096 + vwoff + it * 1024) = vr[12 + it]; }
            f32x16 o0, o1;
#pragma unroll
            for (int i = 0; i < 16; ++i) { o0[i] = 0.f; o1[i] = 0.f; }
            o0 = __builtin_amdgcn_mfma_f32_32x32x16_bf16(qc[0], wf[0][0], o0, 0, 0, 0); o0 = __builtin_amdgcn_mfma_f32_32x32x16_bf16(qc[1], wf[0][1], o0, 0, 0, 0);
            o1 = __builtin_amdgcn_mfma_f32_32x32x16_bf16(qc[0], wf[1][0], o1, 0, 0, 0); o1 = __builtin_amdgcn_mfma_f32_32x32x16_bf16(qc[1], wf[1][1], o1, 0, 0, 0);
#pragma unroll
            for (int kt = 0; kt < 4; ++kt) if (kt <= qt) {
                f32x16 s;
#pragma unroll
                for (int i = 0; i < 16; ++i) s[i] = 0.f;
                s = __builtin_amdgcn_mfma_f32_32x32x16_bf16(kf[kt][0], qc[0], s, 0, 0, 0); s = __builtin_amdgcn_mfma_f32_32x32x16_bf16(kf[kt][1], qc[1], s, 0, 0, 0);
                if (kt == qt) {
#pragma unroll
                    for (int i = 0; i < 16; ++i) if ((i & 3) + 8 * (i >> 2) + 4 * hh > r32) s[i] = 0.f; }
                bf16x8_t pf[2];
#pragma unroll
                for (int sx = 0; sx < 2; ++sx) { u32x4 w4; w4.x = cvtpk(s[8 * sx + 0], s[8 * sx + 1]); w4.y = cvtpk(s[8 * sx + 2], s[8 * sx + 3]); w4.z = cvtpk(s[8 * sx + 4], s[8 * sx + 5]); w4.w = cvtpk(s[8 * sx + 6], s[8 * sx + 7]); pf[sx] = __builtin_bit_cast(bf16x8_t, w4); }
#pragma unroll
                for (int sx = 0; sx < 2; ++sx)
#pragma unroll
                    for (int db = 0; db < 2; ++db) { const bf16x8_t vf = tr2((const LAS unsigned char*)vs + kt * 4096 + vroff + sx * 2048 + ((db ^ tsw) * 64), 1024);
                        if (db == 0) o0 = __builtin_amdgcn_mfma_f32_32x32x16_bf16(pf[sx], vf, o0, 0, 0, 0); else o1 = __builtin_amdgcn_mfma_f32_32x32x16_bf16(pf[sx], vf, o1, 0, 0, 0); }
            }
            float* osc = (float*)(vs + (qt == 3 ? 0 : 3 * 4096));
            f32x4 ov[2][4]; float ss = 0.f;
#pragma unroll
            for (int db = 0; db < 2; ++db) {
#pragma unroll
                for (int i = 0; i < 16; ++i) { const int qi = (i & 3) + 8 * (i >> 2) + 4 * hh; osc[qi * 32 + r32] = db == 0 ? o0[i] : o1[i]; }
#pragma unroll
                for (int k = 0; k < 4; ++k) { ov[db][k] = *(const f32x4*)(osc + erow * 32 + 16 * eh16 + 4 * k); ss += (ov[db][k].x * ov[db][k].x + ov[db][k].y * ov[db][k].y) + (ov[db][k].z * ov[db][k].z + ov[db][k].w * ov[db][k].w); } }
            ss += __shfl_xor(ss, 1);
            const float rs = __builtin_amdgcn_rsqf(ss * (1.0f / 64.0f) + EPS);
            bf16* mp = mix + (row0 + 32 * qt + erow) * D + MX_RET + h * 64 + 16 * eh16; const float* rgp = retg + h * 64 + 16 * eh16;
#pragma unroll
            for (int k = 0; k < 4; ++k) { const int db = k >> 1, c8 = 8 * (k & 1); float g[8], o[8]; unpack8(gv[k], g); const f32x4 ra = *(const f32x4*)(rgp + 32 * db + c8), rb = *(const f32x4*)(rgp + 32 * db + c8 + 4);
                const f32x4 a = ov[db][2 * (k & 1)] * rs * ra, c4 = ov[db][2 * (k & 1) + 1] * rs * rb;
                o[0] = a.x; o[1] = a.y; o[2] = a.z; o[3] = a.w; o[4] = c4.x; o[5] = c4.y; o[6] = c4.z; o[7] = c4.w;
#pragma unroll
                for (int e = 0; e < 8; ++e) o[e] *= g[e] * __builtin_amdgcn_rcpf(1.0f + __expf(-g[e]));
                *(u32x4*)(mp + 32 * db + c8) = pack8(o); }
        }
        __syncthreads();
    }
    __syncthreads();
}
template <int WHICH> __device__ __forceinline__ void ph_gemm(const P& p, int layer, unsigned char* lds, int bid, int G, unsigned* arc = nullptr, const XcdBarrier* xbp = nullptr) {
    unsigned char* wb = p.ws + WS_W + (size_t)layer * W_LAYER; float* ssq = (float*)(p.ws + WS_SSQ); bf16* xb = (bf16*)(p.ws + WS_XB);
    pg8::StaticOrder So;
    LAS float* rtab = (LAS float*)((LAS unsigned char*)lds + (WHICH == 0 ? 139264 : 131072));
    if constexpr (WHICH == 0) { pg8::Gemm g{xb, (const bf16*)(wb + W_IN), M, INW, D, D}; So.init(M, INW, G, bid, (G % 8 == 0) ? 1 : 0, (G == 256) ? arc : nullptr, xbp); rstd_prepass(So, ssq, rtab); EpiInProj E{(bf16*)(p.ws + WS_U), rtab, (const float2*)(p.ws + WS_ROPE), p.in[7] + layer * 64, p.in[8] + layer * 64, 0};
        pg8::gemm_phase<EpiInProj, pg8::StaticOrder, true, true>((LAS unsigned char*)lds, g, So, E); }
    if constexpr (WHICH == 1) { pg8::Gemm g{(const bf16*)(p.ws + WS_MIX), (const bf16*)(wb + W_OUT), M, D, D, D}; So.init(M, D, G, bid); EpiRes E{layer == 0 ? p.in[0] : nullptr, xb, ssq, nullptr};
        pg8::gemm_phase<EpiRes, pg8::StaticOrder, true, true>((LAS unsigned char*)lds, g, So, E); }
    if constexpr (WHICH == 2) { pg8::Gemm g{xb, (const bf16*)(wb + W_F1), M, FF, D, D}; So.init(M, FF, G, bid); rstd_prepass(So, ssq, rtab); EpiNormBf16<1> E{(bf16*)(p.ws + WS_H), rtab, HP, 0};
        pg8::gemm_phase<EpiNormBf16<1>, pg8::StaticOrder, true, true>((LAS unsigned char*)lds, g, So, E); }
    if constexpr (WHICH == 3) { pg8::Gemm g{(const bf16*)(p.ws + WS_H), (const bf16*)(wb + W_F2), M, D, FF, HP}; So.init(M, D, G, bid); EpiRes E{nullptr, xb, ssq, layer + 1 == DEPTH ? p.out : nullptr};
        pg8::gemm_phase<EpiRes, pg8::StaticOrder, true, true>((LAS unsigned char*)lds, g, So, E); }
}


constexpr int CW_BAR = 4096;
constexpr int LDS_BYTES = 147456;
constexpr int LDS_MISC = LDS_BYTES - 256;
#define GRID_SYNC() xcd_barrier(bar)
__global__ void __launch_bounds__(512, 2) k_mega(P p) {
    extern __shared__ __attribute__((aligned(16))) unsigned char lds[];
    cg::grid_group grid = cg::this_grid();
    const int bid = (int)blockIdx.x, G = (int)gridDim.x;
    volatile LAS unsigned* MISC = (volatile LAS unsigned*)((LAS unsigned char*)lds + LDS_MISC);
    if (threadIdx.x < 64) MISC[threadIdx.x] = 0u;
    __syncthreads();
    if (bid == 0) for (int i = threadIdx.x; i < XCD_BAR_WORDS + XB_EV_WORDS * 2 * DEPTH; i += 512) ((unsigned*)(p.ws + WS_CTL))[CW_BAR + i] = 0u;
    ph_wconv(p, lds, bid, G); __syncthreads();
    ph_xprep(p, bid, G);
    ph_attn_tables(p, bid, G);
    grid.sync();
    XcdBarrier bar = xcd_barrier_post((unsigned*)(p.ws + WS_CTL) + CW_BAR, MISC + 8);
    for (int layer = 0; layer < DEPTH; ++layer) {
        unsigned* arr = (unsigned*)(p.ws + WS_CTL) + CW_BAR + XCD_BAR_WORDS + XB_EV_WORDS * (2 * layer);
        unsigned* arc = arr + XB_EV_WORDS;
        ph_gemm<0>(p, layer, lds, bid, G, arc, &bar);
#pragma unroll 1
        for (int cm = 0; cm < sgpr_opaque(2); ++cm) {
            if (cm == 0) { if (G == 256 && bid >= 128) split_wait(arc, (unsigned)G, (unsigned*)(p.ws + WS_CTL) + CW_BAR); }
            else { GRID_SYNC(); ph_retI(p, lds, bid, G); split_arrive(bar, arr); }
            ph_conv(p, layer, lds, bid, G, cm == 0 ? 1 : 0);
        }
        ph_attn(p, layer, lds, bid, G);
        split_wait(arr, (unsigned)G, (unsigned*)(p.ws + WS_CTL) + CW_BAR);
        ph_retII(p, layer, lds, bid, G);
        GRID_SYNC();
        ph_gemm<1>(p, layer, lds, bid, G);
        GRID_SYNC();
        ph_gemm<2>(p, layer, lds, bid, G);
        GRID_SYNC();
        ph_gemm<3>(p, layer, lds, bid, G);
        if (layer + 1 < DEPTH) GRID_SYNC();
    }
}
extern "C" void kernel_launch(void* const* d_in, const int* in_sizes, int n_in, void* d_out, int out_size, void* d_ws, size_t ws_size, hipStream_t stream) {
    static int grid = 0;
    if (grid == 0) {
        if (n_in != 14 || in_sizes[0] != M * D || out_size != M * D || ws_size < WS_END) { fprintf(stderr, "kernel_launch: unexpected shapes (n_in %d, in0 %d, out %d, ws %zu)\n", n_in, n_in > 0 ? in_sizes[0] : -1, out_size, ws_size); grid = -1; return; }
        int dev = 0, cus = 0, per_cu = 0;
        if (hipGetDevice(&dev) != hipSuccess || hipDeviceGetAttribute(&cus, hipDeviceAttributeMultiprocessorCount, dev) != hipSuccess) { fprintf(stderr, "kernel_launch: device query failed\n"); grid = -1; return; }
        if (hipFuncSetAttribute((const void*)k_mega, hipFuncAttributeMaxDynamicSharedMemorySize, LDS_BYTES) != hipSuccess) { fprintf(stderr, "kernel_launch: hipFuncSetAttribute failed\n"); grid = -1; return; }
        if (hipOccupancyMaxActiveBlocksPerMultiprocessor(&per_cu, (const void*)k_mega, 512, LDS_BYTES) != hipSuccess || per_cu < 1) { fprintf(stderr, "kernel_launch: occupancy query says %d blocks per CU\n", per_cu); grid = -1; return; }
        grid = cus;
        fprintf(stderr, "kernel_launch: %d CUs, occupancy %d per CU, grid %d\n", cus, per_cu, grid);
    }
    if (grid < 0) return;
    P p{}; for (int i = 0; i < 14; ++i) p.in[i] = (const float*)d_in[i];
    p.out = (float*)d_out; p.ws = (unsigned char*)d_ws;
    void* args[] = {&p};
    const hipError_t e = hipLaunchCooperativeKernel((const void*)k_mega, dim3(grid), dim3(512), args, LDS_BYTES, stream);
    if (e != hipSuccess) fprintf(stderr, "kernel_launch: cooperative launch failed: %s (grid %d)\n", hipGetErrorString(e), grid);
}
```

```cpp
#include <hip/hip_runtime.h>
#include <hip/hip_cooperative_groups.h>
#include <cstdio>
#include <cstdint>
namespace cg = cooperative_groups;
#define GAS __attribute__((address_space(1)))
#define LAS __attribute__((address_space(3)))
typedef GAS unsigned gu32;
#define XB_TMO      128
#define XB_XCNT(j)  (256  + 64 * (j))
#define XB_XSUB(j)  (1280 + 64 * (j))
#define XB_XGEN(j)  (2304 + 64 * (j))
#define XB_TOP      3328
#define XB_TOPGEN   3392
#define XCD_BAR_WORDS 3456
#define XB_SPIN_CAP (1u << 21)

__device__ __forceinline__ unsigned xb_ld(unsigned* p)              { return __hip_atomic_load(p, __ATOMIC_RELAXED, __HIP_MEMORY_SCOPE_AGENT); }
__device__ __forceinline__ unsigned xb_add(unsigned* p, unsigned v) { return __hip_atomic_fetch_add(p, v, __ATOMIC_RELAXED, __HIP_MEMORY_SCOPE_AGENT); }
__device__ __forceinline__ unsigned xb_xcc_id() { return (unsigned)__builtin_amdgcn_s_getreg((3 << 11) | 20) & 0xFu; }
#define XB_SPIN(cond, bar) do { unsigned _sp = 0; while (cond) { __builtin_amdgcn_s_sleep(1); \
    if ((++_sp & 255u) == 0u) { if (xb_ld(&(bar)[XB_TMO])) break; if (_sp > XB_SPIN_CAP) { atomicAdd(&(bar)[XB_TMO], 1u); break; } } } } while (0)

struct XcdBarrier {
    unsigned* bar; unsigned x;
    volatile LAS unsigned* st;
};

__device__ __forceinline__ XcdBarrier xcd_barrier_post(unsigned* bar, volatile LAS unsigned* st) {
    XcdBarrier b; b.bar = bar; b.x = xb_xcc_id(); b.st = st;
    if (threadIdx.x == 0) (void)xb_add(&bar[XB_XCNT(b.x)], 1u);
    return b;
}
__device__ __forceinline__ void xcd_barrier_complete(unsigned* bar, unsigned x, unsigned& nloc, unsigned& nx) {
    const unsigned G = gridDim.x * gridDim.y * gridDim.z;
    unsigned sum, cnt, mine, sp = 0u;
    for (;;) {
        sum = 0u; cnt = 0u; mine = 0u;
#pragma unroll
        for (unsigned j = 0; j < 16; ++j) { const unsigned c = xb_ld(&bar[XB_XCNT(j)]); sum += c; cnt += (c > 0u) ? 1u : 0u; mine = (j == x) ? c : mine; }
        if (sum == G) break;
        __builtin_amdgcn_s_sleep(1);
        if ((++sp & 255u) == 0u) { if (xb_ld(&bar[XB_TMO])) break; if (sp > XB_SPIN_CAP) { atomicAdd(&bar[XB_TMO], 1u); break; } }
    }
    nloc = mine > 0u ? mine : 1u; nx = cnt > 0u ? cnt : 1u;
}

__device__ __forceinline__ void xcd_barrier(const XcdBarrier& b) {
    asm volatile("s_waitcnt vmcnt(0)" ::: "memory");
    __syncthreads();
    if (threadIdx.x == 0) {
        unsigned* bar = b.bar;
        __builtin_amdgcn_s_waitcnt(0);
        unsigned nloc = b.st[0], nx = b.st[1];
        if (nloc == 0u) { xcd_barrier_complete(bar, b.x, nloc, nx); b.st[0] = nloc; b.st[1] = nx; }
        const unsigned old = xb_add(&bar[XB_XSUB(b.x)], 1u);
        const unsigned gen = old / nloc;
        if (old + 1u == (gen + 1u) * nloc) {
            __builtin_amdgcn_fence(__ATOMIC_RELEASE, "agent");
            asm volatile("s_waitcnt vmcnt(0)" ::: "memory");
            const unsigned og = xb_add(&bar[XB_TOP], 1u);
            const unsigned tg = og / nx;
            if (og + 1u == (tg + 1u) * nx) xb_add(&bar[XB_TOPGEN], 1u);
            else XB_SPIN(xb_ld(&bar[XB_TOPGEN]) == tg, bar);
            __builtin_amdgcn_fence(__ATOMIC_ACQUIRE, "agent");
            xb_add(&bar[XB_XGEN(b.x)], 1u);
            asm volatile("s_waitcnt vmcnt(0)" ::: "memory");
        } else {
            XB_SPIN(xb_ld(&bar[XB_XGEN(b.x)]) == gen, bar);
            __builtin_amdgcn_fence(__ATOMIC_ACQUIRE, "agent");
            asm volatile("s_waitcnt vmcnt(0)" ::: "memory");
        }
    }
    __syncthreads();
}

#define XB_EV_WORDS 1088
__device__ __forceinline__ void split_arrive(const XcdBarrier& b, unsigned* ev) {
    asm volatile("s_waitcnt vmcnt(0)" ::: "memory");
    __syncthreads();
    if (threadIdx.x == 0) {
        unsigned nloc = b.st[0], nx = b.st[1];
        if (nloc == 0u) { xcd_barrier_complete(b.bar, b.x, nloc, nx); b.st[0] = nloc; b.st[1] = nx; }
        const unsigned old = xb_add(&ev[64u * (1u + b.x)], 1u);
        if (old + 1u == nloc) { __builtin_amdgcn_fence(__ATOMIC_RELEASE, "agent"); asm volatile("s_waitcnt vmcnt(0)" ::: "memory"); (void)xb_add(&ev[0], nloc); }
    }
}
__device__ __forceinline__ void split_wait(unsigned* ctr, unsigned G, unsigned* bar) {
    if (threadIdx.x == 0) { XB_SPIN(xb_ld(ctr) < G, bar); __builtin_amdgcn_fence(__ATOMIC_ACQUIRE, "agent"); asm volatile("s_waitcnt vmcnt(0)" ::: "memory"); }
    __syncthreads();
}
namespace pg8 {
#define PG8_LAS __attribute__((address_space(3)))
typedef unsigned short bf16_t;
typedef short bf16x8 __attribute__((ext_vector_type(8)));
typedef float f32x4 __attribute__((ext_vector_type(4)));
typedef unsigned u32x4 __attribute__((ext_vector_type(4)));
constexpr int BM = 256, BK = 64, HALF = 128, HTB = HALF * BK * 2  , STAGE_BYTES = 8 * HTB, NXCD = 8, WGM = 8;

__host__ __device__ __forceinline__ int lds_byte(int r, int c) { const int st = (r >> 4) * 2 + (c >> 5), rr = r & 15, cc = c & 31, ob = rr * 64 + cc * 2; return st * 1024 + (ob ^ (((ob >> 9) & 1) << 5)); }
__host__ __device__ __forceinline__ void stage_rc(int b, int& R, int& C) { const int st = b / 1024, sb = b % 1024, swz = sb ^ (((sb >> 9) & 1) << 5); R = (st >> 1) * 16 + swz / 64; C = (st & 1) * 32 + (swz % 64) / 2; }
__host__ __device__ __forceinline__ int perm32(int rho) { const int n = rho >> 4, i = rho & 15; return 8 * (i >> 2) + 4 * n + (i & 3); }

struct Unit { int pm, pn; };
struct Gemm { const bf16_t* A; const bf16_t* Bt; int M, N, K, lda; };

struct StaticOrder {
    int nM, nN, nwg, G, c, convfirst; unsigned* arr; const XcdBarrier* xbp; mutable int ndone;
    __host__ __device__ void init(int M, int N, int G_, int c_, int convfirst_ = 0, unsigned* arr_ = nullptr, const XcdBarrier* xbp_ = nullptr) { nM = M / BM; nN = N / BM; nwg = nM * nN; G = G_; c = c_; convfirst = convfirst_; arr = arr_; xbp = xbp_; ndone = 0; }
    __host__ __device__ bool next(int i, Unit& u) const {
        const long L = (long)i * G + c; if (L >= nwg) return false;
        if (convfirst) {
            const int xcd = (int)(L % NXCD), off = (int)(L / NXCD), per = nM / NXCD;
            if (off < 2 * per) { u.pm = xcd * per + off % per; u.pn = off / per; }
            else { const int o2 = off - 2 * per, gs = WGM * (nN - 2), grp = o2 / gs, w = o2 % gs; u.pm = xcd * per + grp * WGM + w % WGM; u.pn = 2 + w / WGM; }
            return true; }
        int wgid = (int)L; { const int q = nwg / NXCD, r = nwg % NXCD, xcd = wgid % NXCD, off = wgid / NXCD; wgid = (xcd < r ? xcd * (q + 1) : r * (q + 1) + (xcd - r) * q) + off; }
        const int nig = WGM * nN, gid = wgid / nig, fm = gid * WGM, gsz = (nM - fm) < WGM ? (nM - fm) : WGM;
        u.pm = fm + ((wgid % nig) % gsz); u.pn = (wgid % nig) / gsz; return true;
    }
    __device__ __forceinline__ void a_ready(const Unit&) const {}
    __device__ __forceinline__ void done(const Unit&) const { if (arr != nullptr && ndone++ == 0) split_arrive(*xbp, arr); }
};

__device__ __forceinline__ unsigned cvt_pk_bf16(float lo, float hi) { unsigned r; asm volatile("v_cvt_pk_bf16_f32 %0, %1, %2" : "=v"(r) : "v"(lo), "v"(hi)); return r; }
typedef float f32x2 __attribute__((ext_vector_type(2)));
template <class Epi, class Sched, bool ALIGN_EPI = false, bool SP2 = false>
__device__ __forceinline__ void gemm_phase(PG8_LAS unsigned char* lds, const Gemm g, const Sched& S, const Epi& E) {
    int tid_ = threadIdx.x; asm volatile("" : "+v"(tid_)); const int tid = tid_, wid = __builtin_amdgcn_readfirstlane(tid >> 6), lane = tid & 63, wr = wid >> 2, wc = wid & 3, fr = lane & 15, fq = lane >> 4;
    const int K = g.K, nt = K / BK;
    unsigned voffA[2], voffB[2];
#pragma unroll
    for (int i = 0; i < 2; ++i) { int R, C; stage_rc(tid * 16 + i * 8192, R, C); const int Rb = Epi::PERM ? (2 * (R & ~31) + perm32(R & 31)) : R;
        voffA[i] = (unsigned)(R * g.lda + C) * 2u; voffB[i] = (unsigned)(Rb * K + C) * 2u; }
    const size_t kstep = (size_t)(BK * 2);
    const size_t hstep = (size_t)HALF * g.lda * 2;
    const size_t tstep = 2 * hstep, tstepB = (size_t)BM * K * 2;
    const size_t hstepB = Epi::PERM ? (size_t)32 * K * 2 : (size_t)HALF * K * 2;
    const unsigned ldsw = (unsigned)wid * 1024u;
    const int aoff = lds_byte(wr * 64 + fr, fq * 8), boff = lds_byte(wc * 32 + fr, fq * 8);
#define PG8_SA(b, h) (((b) * 2 + (h)) * HTB)
#define PG8_SB(b, h) ((4 + (b) * 2 + (h)) * HTB)
#define PG8_STAGE(bufoff, gbase, voff) do { _Pragma("unroll") for (int _i = 0; _i < 2; ++_i) \
        __builtin_amdgcn_global_load_lds((const unsigned*)((const char*)(gbase) + (voff)[_i]), (PG8_LAS unsigned*)(lds + (bufoff) + ldsw + _i * 8192), 16, 0, 0); } while (0)
#define PG8_LDA(dst, b, h) do { _Pragma("unroll") for (int m = 0; m < 4; ++m) _Pragma("unroll") for (int k = 0; k < 2; ++k) dst[m][k] = *(const PG8_LAS bf16x8*)(lds + PG8_SA(b, h) + aoff + m * 2048 + k * 1024); } while (0)
#define PG8_LDB(dst, b, h) do { _Pragma("unroll") for (int n = 0; n < 2; ++n) _Pragma("unroll") for (int k = 0; k < 2; ++k) dst[n][k] = *(const PG8_LAS bf16x8*)(lds + PG8_SB(b, h) + boff + n * 2048 + k * 1024); } while (0)
#define PG8_MMA(ai, bj, At, Bt) do { __builtin_amdgcn_s_setprio(1); _Pragma("unroll") for (int m = 0; m < 4; ++m) _Pragma("unroll") for (int n = 0; n < 2; ++n) _Pragma("unroll") for (int k = 0; k < 2; ++k) \
        acc[ai][bj][m][n] = __builtin_amdgcn_mfma_f32_16x16x32_bf16(Bt[n][k], At[m][k], acc[ai][bj][m][n], 0, 0, 0); __builtin_amdgcn_s_setprio(0); } while (0)
#define PG8_WAIT_V(n) asm volatile("s_waitcnt vmcnt(" #n ")" ::: "memory")
#define PG8_WAIT_L(n) asm volatile("s_waitcnt lgkmcnt(" #n ")" ::: "memory")
#define PG8_BAR __builtin_amdgcn_s_barrier()
#define PG8_SCHED __builtin_amdgcn_sched_barrier(0)
    Unit cur, nxt; int ui = 0;
    if (!S.next(0, cur)) return;
    f32x4 acc[2][2][4][2];
#pragma unroll
    for (int a = 0; a < 2; ++a)
#pragma unroll
        for (int b = 0; b < 2; ++b)
#pragma unroll
            for (int m = 0; m < 4; ++m)
#pragma unroll
                for (int n = 0; n < 2; ++n) acc[a][b][m][n] = (f32x4){0.f, 0.f, 0.f, 0.f};
    bf16x8 At[4][2], B0[2][2], B1[2][2];
    const char* cA = (const char*)g.A + (size_t)cur.pm * tstep; const char* cB = (const char*)g.Bt + (size_t)cur.pn * tstepB;
    S.a_ready(cur);
    if constexpr (SP2) {
        PG8_STAGE(PG8_SB(0, 0), cB, voffB); PG8_STAGE(PG8_SB(0, 1), cB + hstepB, voffB); PG8_STAGE(PG8_SA(0, 0), cA, voffA); PG8_STAGE(PG8_SA(0, 1), cA + hstep, voffA);
        if (wr == 1) PG8_BAR;
        PG8_WAIT_V(2); PG8_BAR;
        PG8_STAGE(PG8_SB(1, 0), cB + kstep, voffB); PG8_STAGE(PG8_SA(1, 0), cA + kstep, voffA); PG8_STAGE(PG8_SB(1, 1), cB + hstepB + kstep, voffB);
        PG8_WAIT_V(6); PG8_BAR;
    } else {
        PG8_STAGE(PG8_SB(0, 0), cB, voffB); PG8_STAGE(PG8_SA(0, 0), cA, voffA); PG8_STAGE(PG8_SB(0, 1), cB + hstepB, voffB); PG8_STAGE(PG8_SA(0, 1), cA + hstep, voffA);
        if (wr == 1) PG8_BAR;
        PG8_WAIT_V(4); PG8_BAR;
        PG8_STAGE(PG8_SB(1, 0), cB + kstep, voffB); PG8_STAGE(PG8_SA(1, 0), cA + kstep, voffA); PG8_STAGE(PG8_SB(1, 1), cB + hstepB + kstep, voffB);
        PG8_WAIT_V(6); PG8_BAR;
    }
    for (;;) {
        const bool has_next = S.next(ui + 1, nxt);
        const char* nA = has_next ? (const char*)g.A + (size_t)nxt.pm * tstep : cA; const char* nB = has_next ? (const char*)g.Bt + (size_t)nxt.pn * tstepB : cB;
        for (int t = 0; t < nt; t += 2) {
            asm volatile(".p2align 6");
            const bool last = (t == nt - 2);
            const char* a1 = cA + (size_t)(t + 1) * kstep;
            const char* a2 = last ? nA : cA + (size_t)(t + 2) * kstep; const char* b2 = last ? nB : cB + (size_t)(t + 2) * kstep;
            const char* a3 = a2 + kstep; const char* b3 = b2 + kstep;
            if (last && has_next) S.a_ready(nxt);
            if constexpr (SP2) {
            PG8_LDB(B0, 0, 0); PG8_LDB(B1, 0, 1); PG8_SCHED; PG8_LDA(At, 0, 0); PG8_STAGE(PG8_SA(1, 1), a1 + hstep, voffA);
            PG8_WAIT_V(8); PG8_WAIT_L(0); PG8_BAR; PG8_MMA(0, 0, At, B0); PG8_MMA(0, 1, At, B1); PG8_BAR; PG8_SCHED;
            PG8_LDA(At, 0, 1); PG8_STAGE(PG8_SB(0, 0), b2, voffB); PG8_STAGE(PG8_SB(0, 1), b2 + hstepB, voffB); PG8_STAGE(PG8_SA(0, 0), a2, voffA);
            PG8_WAIT_V(8); PG8_WAIT_L(0); PG8_BAR; PG8_MMA(1, 0, At, B0); PG8_MMA(1, 1, At, B1); PG8_BAR; PG8_SCHED;
            PG8_LDB(B0, 1, 0); PG8_LDB(B1, 1, 1); PG8_SCHED; PG8_LDA(At, 1, 0); PG8_STAGE(PG8_SA(0, 1), a2 + hstep, voffA);
            PG8_WAIT_V(8); PG8_WAIT_L(0); PG8_BAR; PG8_MMA(0, 0, At, B0); PG8_MMA(0, 1, At, B1); PG8_BAR; PG8_SCHED;
            PG8_LDA(At, 1, 1); PG8_STAGE(PG8_SB(1, 0), b3, voffB); PG8_STAGE(PG8_SB(1, 1), b3 + hstepB, voffB); PG8_STAGE(PG8_SA(1, 0), a3, voffA);
            PG8_WAIT_V(8); PG8_WAIT_L(0); PG8_BAR; PG8_MMA(1, 0, At, B0); PG8_MMA(1, 1, At, B1); PG8_BAR; PG8_SCHED;
            } else {
            PG8_LDB(B0, 0, 0); PG8_SCHED; PG8_LDA(At, 0, 0); PG8_STAGE(PG8_SA(1, 1), a1 + hstep, voffA);
            PG8_WAIT_L(8); PG8_BAR; PG8_WAIT_L(0); PG8_MMA(0, 0, At, B0); PG8_BAR; PG8_SCHED;
            PG8_LDB(B1, 0, 1); PG8_STAGE(PG8_SB(0, 0), b2, voffB);
            PG8_BAR; PG8_WAIT_L(0); PG8_MMA(0, 1, At, B1); PG8_BAR;
            PG8_LDA(At, 0, 1); PG8_STAGE(PG8_SA(0, 0), a2, voffA);
            PG8_BAR; PG8_WAIT_L(0); PG8_MMA(1, 0, At, B0); PG8_BAR; PG8_SCHED;
            PG8_STAGE(PG8_SB(0, 1), b2 + hstepB, voffB);
            PG8_WAIT_V(6); PG8_BAR; PG8_MMA(1, 1, At, B1); PG8_BAR;
            PG8_LDB(B0, 1, 0); PG8_SCHED; PG8_LDA(At, 1, 0); PG8_STAGE(PG8_SA(0, 1), a2 + hstep, voffA);
            PG8_WAIT_L(8); PG8_BAR; PG8_WAIT_L(0); PG8_MMA(0, 0, At, B0); PG8_BAR; PG8_SCHED;
            PG8_LDB(B1, 1, 1); PG8_STAGE(PG8_SB(1, 0), b3, voffB);
            PG8_BAR; PG8_WAIT_L(0); PG8_MMA(0, 1, At, B1); PG8_BAR;
            PG8_LDA(At, 1, 1); PG8_STAGE(PG8_SA(1, 0), a3, voffA);
            PG8_BAR; PG8_WAIT_L(0); PG8_MMA(1, 0, At, B0); PG8_BAR; PG8_SCHED;
            PG8_STAGE(PG8_SB(1, 1), b3 + hstepB, voffB);
            PG8_WAIT_V(6); PG8_BAR; PG8_MMA(1, 1, At, B1); PG8_BAR;
            }
        }
        if constexpr (ALIGN_EPI) { if (wr == 0) PG8_BAR; }
        if constexpr (!Epi::AFTER_DRAIN) { int fr_ = fr, fq_ = fq; asm volatile("" : "+v"(fr_), "+v"(fq_));
            E(acc, cur, wr, wc, fr_, fq_, !has_next  ); S.done(cur); }
        if (!has_next) break;
#pragma unroll
        for (int a = 0; a < 2; ++a)
#pragma unroll
            for (int b = 0; b < 2; ++b)
#pragma unroll
                for (int m = 0; m < 4; ++m)
#pragma unroll
                    for (int n = 0; n < 2; ++n) acc[a][b][m][n] = (f32x4){0.f, 0.f, 0.f, 0.f};
        cur = nxt; cA = nA; cB = nB; ++ui;
        if constexpr (ALIGN_EPI) { if (wr == 1) PG8_BAR; }
    }
    PG8_WAIT_V(0);
    if constexpr (!ALIGN_EPI) { if (wr == 0) PG8_BAR; }
    PG8_BAR;
    if constexpr (Epi::AFTER_DRAIN) { E.fused(acc, cur, wr, wc, fr, fq, lds, wid, lane); S.done(cur); }
#undef PG8_SA
#undef PG8_SB
#undef PG8_STAGE
#undef PG8_LDA
#undef PG8_LDB
#undef PG8_MMA
#undef PG8_WAIT_V
#undef PG8_WAIT_L
#undef PG8_BAR
#undef PG8_SCHED
}
}
typedef unsigned short bf16;
typedef float f32x4 __attribute__((ext_vector_type(4)));
typedef unsigned u32x4 __attribute__((ext_vector_type(4)));
constexpr int NB = 2, S = 16384, D = 1024, M = NB * S, INW = 2816, FF = 4096, DEPTH = 2;
constexpr int C_A = 0, C_G = 256, C_RQ = 512, C_RK = 704, C_RV = 896, C_RG = 1280, C_AQ = 1664, C_AK = 2048, C_AV = 2432;
constexpr int MX_CONV = 0, MX_RET = 256, MX_ATT = 640;
constexpr float EPS = 1e-6f;
constexpr size_t MiB = 1u << 20;
constexpr size_t WS_CTL = 0, CTL_BYTES = 1 * MiB;
constexpr size_t WS_W = 2 * MiB;
constexpr size_t W_LAYER = 24641536, W_IN = 0, W_OUT = 5767168, W_F1 = 7864320, W_F2 = 16252928;
constexpr size_t WS_SSQ = 50 * MiB;
constexpr size_t WS_ATAB = 56 * MiB;
constexpr size_t WS_ROPE = 52 * MiB;
constexpr size_t WS_XB = 64 * MiB;
constexpr int HP = FF + 64;
constexpr size_t WS_H = 128 * MiB;
constexpr size_t WS_U = 128 * MiB;
constexpr size_t WS_MIX = 304 * MiB;
constexpr size_t WS_KV = 408 * MiB;
constexpr size_t WS_ST = 420 * MiB;
constexpr size_t WS_END = 432 * MiB;

struct P { const float* in[14]; float* out; unsigned char* ws; };

__device__ __forceinline__ float bf_lo(unsigned w) { return __uint_as_float(w << 16); }
__device__ __forceinline__ float bf_hi(unsigned w) { return __uint_as_float(w & 0xffff0000u); }
__device__ __forceinline__ unsigned f2bf(float f) { unsigned u = __float_as_uint(f); return (u + 0x7fffu + ((u >> 16) & 1u)) >> 16; }
__device__ __forceinline__ unsigned pk2(float lo, float hi) { return f2bf(lo) | (f2bf(hi) << 16); }
__device__ __forceinline__ void unpack8(const u32x4 w, float (&v)[8]) {
    v[0] = bf_lo(w.x); v[1] = bf_hi(w.x); v[2] = bf_lo(w.y); v[3] = bf_hi(w.y); v[4] = bf_lo(w.z); v[5] = bf_hi(w.z); v[6] = bf_lo(w.w); v[7] = bf_hi(w.w); }
__device__ __forceinline__ u32x4 pack8(const float (&v)[8]) { u32x4 w; w.x = pk2(v[0], v[1]); w.y = pk2(v[2], v[3]); w.z = pk2(v[4], v[5]); w.w = pk2(v[6], v[7]); return w; }
__device__ __forceinline__ float wave_sum(float v) {
#pragma unroll
    for (int o = 1; o < 64; o <<= 1) v += __shfl_xor(v, o);
    return v; }
__device__ __forceinline__ int sgpr_opaque(int v) { asm volatile("" : "+s"(v)); return v; }
__device__ __forceinline__ int tid_opaque() { int t = threadIdx.x; asm volatile("" : "+v"(t)); return t; }
__device__ __forceinline__ float gamma_log2(int h) {
    return h == 0 ? -0.04580368961312479f : h == 1 ? -0.02272007650008353f : h == 2 ? -0.011315313227834146f : h == 3 ? -0.005646563141142063f : h == 4 ? -0.0028205190623786626f : -0.0014095702546713536f; }

__device__ __forceinline__ float ssq_to_rstd(const float* ssq, int row) {
    const f32x4* q = (const f32x4*)(ssq + (size_t)row * 16); const f32x4 a = q[0], b = q[1], c = q[2], d = q[3];
    const float s = ((a.x + a.y) + (a.z + a.w)) + ((b.x + b.y) + (b.z + b.w)) + ((c.x + c.y) + (c.z + c.w)) + ((d.x + d.y) + (d.z + d.w));
    return __builtin_amdgcn_rsqf(s * (1.0f / 1024.0f) + EPS); }
template <class Sched> __device__ __forceinline__ void rstd_prepass(const Sched& So, const float* ssq, LAS float* tab) {
    const int tid = tid_opaque(), row = tid >> 1, hf = tid & 1;
    f32x4 a[8], c[8]; unsigned okm = 0u;
#pragma unroll
    for (int i = 0; i < 8; ++i) { pg8::Unit un; const bool ok = So.next(i, un); const int pm = ok ? un.pm : 0; okm |= (ok ? 1u : 0u) << i;
        const f32x4* q = (const f32x4*)(ssq + (size_t)(pm * 256 + row) * 16 + 8 * hf); a[i] = q[0]; c[i] = q[1]; }
#pragma unroll
    for (int i = 0; i < 8; ++i) {
        float s = ((a[i].x + a[i].y) + (a[i].z + a[i].w)) + ((c[i].x + c[i].y) + (c[i].z + c[i].w));
        s += __builtin_bit_cast(float, __builtin_amdgcn_mov_dpp(__builtin_bit_cast(int, s), 0xB1  , 0xf, 0xf, false));
        if (((okm >> i) & 1u) && hf == 0) tab[i * 256 + row] = __builtin_amdgcn_rsqf(s * (1.0f / 1024.0f) + EPS); }
    __syncthreads();
}
__device__ __forceinline__ void st16_wt(void* ptr, u32x4 v) { asm volatile("global_store_dwordx4 %0, %1, off sc0 sc1\n\ts_nop 1" :: "v"(ptr), "v"(v) : "memory"); }
__device__ __forceinline__ void st8_wt(void* ptr, unsigned long long v) { asm volatile("global_store_dwordx2 %0, %1, off sc0 sc1\n\ts_nop 1" :: "v"(ptr), "v"(v) : "memory"); }
__device__ __forceinline__ unsigned dpp_ror8(unsigned x) { return (unsigned)__builtin_amdgcn_mov_dpp((int)x, 0x128  , 0xf, 0xf, false); }
template <bool NT = false> __device__ __forceinline__ void store_rows_full(bf16* grp  , int ld, int fr, int fq, u32x4 d0, u32x4 d1, bool wt) {
    const bool lo = fr < 8; const u32x4 s = lo ? d1 : d0; u32x4 r; r.x = dpp_ror8(s.x); r.y = dpp_ror8(s.y); r.z = dpp_ror8(s.z); r.w = dpp_ror8(s.w);
    const u32x4 a = lo ? d0 : r, c = lo ? r : d1;
    const unsigned loff = (unsigned)(((fr & 7) * ld + (fr >> 3) * 32 + 8 * fq) * 2);
    char* pa = (char*)grp + loff; char* pc = (char*)(grp + (size_t)8 * ld) + loff;
    if (wt) {
        asm volatile("global_store_dwordx4 %0, %1, off sc0 sc1\n\ts_nop 1" :: "v"(pa), "v"(a) : "memory"); asm volatile("global_store_dwordx4 %0, %1, off sc0 sc1\n\ts_nop 1" :: "v"(pc), "v"(c) : "memory"); }
    else if (NT) { __builtin_nontemporal_store(a, (u32x4*)pa); __builtin_nontemporal_store(c, (u32x4*)pc); } else { *(u32x4*)pa = a; *(u32x4*)pc = c; } }
template <int ACT  > struct EpiNormBf16 {
    static constexpr bool PERM = true, AFTER_DRAIN = false;
    bf16* O; const LAS float* rtab; int ldc; mutable int ord;
    __device__ __forceinline__ void operator()(const pg8::f32x4 (&acc)[2][2][4][2], const pg8::Unit& u, int wr, int wc, int fr, int fq, bool wt) const {
        const int row0 = u.pm * 256 + wr * 64 + fr, col0 = u.pn * 256 + wc * 64 + 8 * fq; const LAS float* rt = rtab + ord * 256 + wr * 64 + fr; ++ord;
#pragma unroll
        for (int ai = 0; ai < 2; ++ai)
#pragma unroll
            for (int m = 0; m < 4; ++m) { const float rs = rt[ai * 128 + m * 16]; u32x4 wv[2];
#pragma unroll
                for (int bj = 0; bj < 2; ++bj) { pg8::f32x4 v0 = acc[ai][bj][m][0] * rs, v1 = acc[ai][bj][m][1] * rs;
                    if (ACT == 1) { const pg8::f32x4 z = {0.f, 0.f, 0.f, 0.f}; v0 = __builtin_elementwise_max(v0, z); v1 = __builtin_elementwise_max(v1, z); v0 = v0 * v0; v1 = v1 * v1; }
                    wv[bj].x = pg8::cvt_pk_bf16(v0[0], v0[1]); wv[bj].y = pg8::cvt_pk_bf16(v0[2], v0[3]); wv[bj].z = pg8::cvt_pk_bf16(v1[0], v1[1]); wv[bj].w = pg8::cvt_pk_bf16(v1[2], v1[3]); }
                store_rows_full<ACT == 1>(O + (size_t)(u.pm * 256 + ai * 128 + wr * 64 + m * 16) * ldc + u.pn * 256 + wc * 64, ldc, fr, fq, wv[0], wv[1], wt); }
    }
};
struct EpiInProj {
    static constexpr bool PERM = true, AFTER_DRAIN = false;
    bf16* O; const LAS float* rtab; const float2* rope; const float* qg; const float* kg; mutable int ord;
    __device__ __forceinline__ void operator()(const pg8::f32x4 (&acc)[2][2][4][2], const pg8::Unit& u, int wr, int wc, int fr, int fq, bool wt) const {
        const int colw = u.pn * 256 + wc * 64;
        const LAS float* rt = rtab + ord * 256 + wr * 64 + fr; ++ord;
        const bool att = colw >= C_AQ && colw < C_AV, isk = colw >= C_AK, rot = colw >= C_RQ && colw < C_RV;
        pg8::f32x4 gn[2][2];
#pragma unroll
        for (int bj = 0; bj < 2; ++bj) { const pg8::f32x4* gp = (const pg8::f32x4*)((isk ? kg : qg) + 32 * bj + 8 * fq); gn[bj][0] = gp[0]; gn[bj][1] = gp[1]; }
#pragma unroll
        for (int ai = 0; ai < 2; ++ai) {
            pg8::f32x4 rc[4][2];
            if (rot) {
#pragma unroll
                for (int m = 0; m < 4; ++m) { const int pos = (u.pm * 256 + ai * 128 + wr * 64 + m * 16 + fr) & (S - 1); const pg8::f32x4* rp4 = (const pg8::f32x4*)(rope + pos * 16 + 4 * fq); rc[m][0] = rp4[0]; rc[m][1] = rp4[1]; } }
#pragma unroll
            for (int m = 0; m < 4; ++m) { const int rl = ai * 128 + wr * 64 + m * 16 + fr, row = u.pm * 256 + rl; const float rs = rt[ai * 128 + m * 16];
                pg8::f32x4 v[2][2];
#pragma unroll
                for (int bj = 0; bj < 2; ++bj) { v[bj][0] = acc[ai][bj][m][0] * rs; v[bj][1] = acc[ai][bj][m][1] * rs; }
                if (att) {
                    float q = 0.f;
#pragma unroll
                    for (int bj = 0; bj < 2; ++bj)
#pragma unroll
                        for (int n = 0; n < 2; ++n) q += (v[bj][n][0] * v[bj][n][0] + v[bj][n][1] * v[bj][n][1]) + (v[bj][n][2] * v[bj][n][2] + v[bj][n][3] * v[bj][n][3]);
                    q += __shfl_xor(q, 16); q += __shfl_xor(q, 32);
                    const float r = __builtin_amdgcn_rsqf(q * (1.0f / 64.0f) + EPS) * (isk ? 1.0f : 0.125f);
#pragma unroll
                    for (int bj = 0; bj < 2; ++bj) { v[bj][0] = v[bj][0] * r * gn[bj][0]; v[bj][1] = v[bj][1] * r * gn[bj][1]; }
                } else {
#pragma unroll
                    for (int bj = 0; bj < 2; ++bj) { const int cg = colw + 32 * bj;
                        if (cg >= C_RQ && cg < C_RV) {
                            const bool rk = cg >= C_RK; const int h = ((rk ? cg - C_RK : cg - C_RQ) >> 5);
                            const int pos = row & (S - 1); const float dq = (float)(pos & 127) * gamma_log2(h); const float sc = rk ? 0.17677669529663687f * __builtin_amdgcn_exp2f(-dq) : __builtin_amdgcn_exp2f(dq);
                            const pg8::f32x4 c01 = rc[m][0], c23 = rc[m][1];
                            const pg8::f32x4 a0 = v[bj][0], a1 = v[bj][1];
                            v[bj][0][0] = (a0[0] * c01[0] - a0[1] * c01[1]) * sc; v[bj][0][1] = (a0[0] * c01[1] + a0[1] * c01[0]) * sc; v[bj][0][2] = (a0[2] * c01[2] - a0[3] * c01[3]) * sc; v[bj][0][3] = (a0[2] * c01[3] + a0[3] * c01[2]) * sc;
                            v[bj][1][0] = (a1[0] * c23[0] - a1[1] * c23[1]) * sc; v[bj][1][1] = (a1[0] * c23[1] + a1[1] * c23[0]) * sc; v[bj][1][2] = (a1[2] * c23[2] - a1[3] * c23[3]) * sc; v[bj][1][3] = (a1[2] * c23[3] + a1[3] * c23[2]) * sc; } } }
                u32x4 wv[2];
#pragma unroll
                for (int bj = 0; bj < 2; ++bj) { wv[bj].x = pg8::cvt_pk_bf16(v[bj][0][0], v[bj][0][1]); wv[bj].y = pg8::cvt_pk_bf16(v[bj][0][2], v[bj][0][3]); wv[bj].z = pg8::cvt_pk_bf16(v[bj][1][0], v[bj][1][1]); wv[bj].w = pg8::cvt_pk_bf16(v[bj][1][2], v[bj][1][3]); }
                store_rows_full(O + (size_t)(u.pm * 256 + ai * 128 + wr * 64 + m * 16) * INW + colw, INW, fr, fq, wv[0], wv[1], wt); }
        }
    }
};
struct EpiRes {
    static constexpr bool PERM = true, AFTER_DRAIN = false;
    const float* xf; bf16* xb; float* ssq; float* outf;
    __device__ __forceinline__ void operator()(const pg8::f32x4 (&acc)[2][2][4][2], const pg8::Unit& u, int wr, int wc, int fr, int fq, bool wt) const {
        const int row0 = u.pm * 256 + wr * 64 + fr, col0 = u.pn * 256 + wc * 64 + 8 * fq;
#pragma unroll
        for (int ai2 = 0; ai2 < 4; ++ai2) { const int ai = ai2 >> 1, mb = 2 * (ai2 & 1);
            pg8::f32x4 ra[2][2][2];
            if (xf) {
#pragma unroll
                for (int m = 0; m < 2; ++m)
#pragma unroll
                    for (int bj = 0; bj < 2; ++bj) { const size_t off = (size_t)(row0 + ai * 128 + (mb + m) * 16) * D + col0 + bj * 32;
                        ra[m][bj][0] = __builtin_nontemporal_load((const pg8::f32x4*)(xf + off)); ra[m][bj][1] = __builtin_nontemporal_load((const pg8::f32x4*)(xf + off + 4)); }
            } else {
                u32x4 w[2][2];
#pragma unroll
                for (int m = 0; m < 2; ++m)
#pragma unroll
                    for (int bj = 0; bj < 2; ++bj) w[m][bj] = *(const u32x4*)(xb + (size_t)(row0 + ai * 128 + (mb + m) * 16) * D + col0 + bj * 32);
#pragma unroll
                for (int m = 0; m < 2; ++m)
#pragma unroll
                    for (int bj = 0; bj < 2; ++bj) { const u32x4 t = w[m][bj]; ra[m][bj][0] = (pg8::f32x4){bf_lo(t.x), bf_hi(t.x), bf_lo(t.y), bf_hi(t.y)}; ra[m][bj][1] = (pg8::f32x4){bf_lo(t.z), bf_hi(t.z), bf_lo(t.w), bf_hi(t.w)}; }
            }
#pragma unroll
            for (int m2 = 0; m2 < 2; ++m2) { const int m = mb + m2, row = row0 + ai * 128 + m * 16; float q = 0.f; u32x4 wv[2] = {{0u, 0u, 0u, 0u}, {0u, 0u, 0u, 0u}};
#pragma unroll
                for (int bj = 0; bj < 2; ++bj) { const size_t off = (size_t)row * D + col0 + bj * 32;
                    const pg8::f32x4 v0 = acc[ai][bj][m][0] + ra[m2][bj][0], v1 = acc[ai][bj][m][1] + ra[m2][bj][1];
                    if (outf) { *(pg8::f32x4*)(outf + off) = v0; *(pg8::f32x4*)(outf + off + 4) = v1; }
                    else { q += (v0[0] * v0[0] + v0[1] * v0[1]) + (v0[2] * v0[2] + v0[3] * v0[3]) + (v1[0] * v1[0] + v1[1] * v1[1]) + (v1[2] * v1[2] + v1[3] * v1[3]);
                        wv[bj].x = pg8::cvt_pk_bf16(v0[0], v0[1]); wv[bj].y = pg8::cvt_pk_bf16(v0[2], v0[3]); wv[bj].z = pg8::cvt_pk_bf16(v1[0], v1[1]); wv[bj].w = pg8::cvt_pk_bf16(v1[2], v1[3]); } }
                if (!outf) store_rows_full(xb + (size_t)(u.pm * 256 + ai * 128 + wr * 64 + m * 16) * D + u.pn * 256 + wc * 64, D, fr, fq, wv[0], wv[1], wt);
                if (!outf) { q += __shfl_xor(q, 16); q += __shfl_xor(q, 32);
                    if (fq == 0) ssq[(size_t)row * 16 + u.pn * 4 + wc] = q; } }
        }
    }
};

__device__ __forceinline__ void transpose_item(const float* W, const float* g, int K, int N, bf16* WT, LAS float* scr, int item, int lane) {
    const int nblk = N / 32, kb = item / nblk, nb = item % nblk, k0 = 64 * kb, n0 = 32 * nb;
    f32x4 v[8];
#pragma unroll
    for (int i = 0; i < 8; ++i) v[i] = __builtin_nontemporal_load((const f32x4*)(W + (size_t)(k0 + 8 * i + (lane >> 3)) * N + n0 + 4 * (lane & 7)));
#pragma unroll
    for (int i = 0; i < 8; ++i) { const int kk = 8 * i + (lane >> 3); const float sc = g ? g[k0 + kk] : 1.0f; LAS float* d = scr + kk * 33 + 4 * (lane & 7);
        d[0] = v[i].x * sc; d[1] = v[i].y * sc; d[2] = v[i].z * sc; d[3] = v[i].w * sc; }
    asm volatile("s_waitcnt lgkmcnt(0)" ::: "memory");
    const int c = lane & 7;
#pragma unroll
    for (int j = 0; j < 4; ++j) { const int n = (lane >> 3) + 8 * j; const LAS float* s = scr + (8 * c) * 33 + n;
        u32x4 o; o.x = pk2(s[0 * 33], s[1 * 33]); o.y = pk2(s[2 * 33], s[3 * 33]); o.z = pk2(s[4 * 33], s[5 * 33]); o.w = pk2(s[6 * 33], s[7 * 33]);
        st16_wt(WT + (size_t)(n0 + n) * K + k0 + 8 * c, o); }
    asm volatile("s_waitcnt lgkmcnt(0)" ::: "memory");
}
__device__ __forceinline__ void ph_wconv(const P& p, unsigned char* lds, int bid, int G) {
    const int tid = tid_opaque(), lane = tid & 63, wave = tid >> 6;
    LAS float* scr = (LAS float*)((LAS unsigned char*)lds + wave * 16384);
    const int gw = bid * 8 + wave, NGW = G * 8;
    for (int it = gw; it < 2 * 6016; it += NGW) {
        const int l = it / 6016; int r = it % 6016; unsigned char* wb = p.ws + WS_W + (size_t)l * W_LAYER;
        if (r < 1408) { transpose_item(p.in[2] + (size_t)l * D * INW, p.in[1] + l * D, D, INW, (bf16*)(wb + W_IN), scr, r, lane); continue; } r -= 1408;
        if (r < 512) { transpose_item(p.in[9] + (size_t)l * D * D, nullptr, D, D, (bf16*)(wb + W_OUT), scr, r, lane); continue; } r -= 512;
        if (r < 2048) { transpose_item(p.in[11] + (size_t)l * D * FF, p.in[10] + l * D, D, FF, (bf16*)(wb + W_F1), scr, r, lane); continue; } r -= 2048;
        transpose_item(p.in[12] + (size_t)l * FF * D, nullptr, FF, D, (bf16*)(wb + W_F2), scr, r, lane);
    }
}
__device__ __forceinline__ void ph_xprep(const P& p, int bid, int G) {
    const int tid = tid_opaque(), lane = tid & 63, wave = tid >> 6; const int gw = bid * 8 + wave, NGW = G * 8;
    const float* x = p.in[0]; bf16* xb = (bf16*)(p.ws + WS_XB); float* ssq = (float*)(p.ws + WS_SSQ);
    for (int m0 = 2 * gw; m0 < M; m0 += 2 * NGW) {
        f32x4 v[2][4];
#pragma unroll
        for (int r = 0; r < 2; ++r) { const f32x4* xr = (const f32x4*)(x + (size_t)(m0 + r) * D) + lane;
#pragma unroll
            for (int j = 0; j < 4; ++j) v[r][j] = __builtin_nontemporal_load(xr + 64 * j); }
#pragma unroll
        for (int r = 0; r < 2; ++r) { const int m = m0 + r; float s = 0.f;
#pragma unroll
            for (int j = 0; j < 4; ++j) s += (v[r][j].x * v[r][j].x + v[r][j].y * v[r][j].y) + (v[r][j].z * v[r][j].z + v[r][j].w * v[r][j].w);
            s = wave_sum(s);
            unsigned long long* o8 = (unsigned long long*)(xb + (size_t)m * D) + lane;
#pragma unroll
            for (int j = 0; j < 4; ++j) st8_wt(o8 + 64 * j, (unsigned long long)pk2(v[r][j].x, v[r][j].y) | ((unsigned long long)pk2(v[r][j].z, v[r][j].w) << 32));
            if (lane < 16) ssq[(size_t)m * 16 + lane] = lane == 0 ? s : 0.f; }
    }
    float2* rope = (float2*)(p.ws + WS_ROPE);
    for (int i = bid * 512 + tid; i < S * 16; i += G * 512) { const int pos = i >> 4, k = i & 15;
        const float e = (float)k / 15.0f; const float inv = 1.0f / powf(10000.0f, e); const float ang = (float)pos * inv;
        rope[i] = make_float2((float)cos((double)ang), (float)sin((double)ang)); }
}
__device__ __forceinline__ float wave_sum_dpp(float v) {
    v += __builtin_bit_cast(float, __builtin_amdgcn_update_dpp(0, __builtin_bit_cast(int, v), 0xB1, 0xf, 0xf, false));
    v += __builtin_bit_cast(float, __builtin_amdgcn_update_dpp(0, __builtin_bit_cast(int, v), 0x4E, 0xf, 0xf, false));
    v += __builtin_bit_cast(float, __builtin_amdgcn_update_dpp(0, __builtin_bit_cast(int, v), 0x141, 0xf, 0xf, false));
    v += __builtin_bit_cast(float, __builtin_amdgcn_update_dpp(0, __builtin_bit_cast(int, v), 0x140, 0xf, 0xf, false));
    const int iv = __builtin_bit_cast(int, v);
    return (__builtin_bit_cast(float, __builtin_amdgcn_readlane(iv, 0)) + __builtin_bit_cast(float, __builtin_amdgcn_readlane(iv, 16))) + (__builtin_bit_cast(float, __builtin_amdgcn_readlane(iv, 32)) + __builtin_bit_cast(float, __builtin_amdgcn_readlane(iv, 48)));
}
__device__ __forceinline__ void ph_conv(const P& p, int layer, unsigned char* lds, int bid, int G, int early  ) {
    const int tid = tid_opaque(); const bf16* u = (const bf16*)(p.ws + WS_U); bf16* mix = (bf16*)(p.ws + WS_MIX);
    float* hl = (float*)lds;
    const int c = tid & 255, half = tid >> 8;
    float W[31];
#pragma unroll
    for (int w = 0; w < 31; ++w) W[w] = p.in[3][(size_t)layer * 31 * 256 + w * 256 + c];
    const float bias = p.in[4][layer * 256 + c], gain = p.in[5][layer * 256 + c];
    int cu0 = bid, cn = early ? 0 : (M / 64 - bid + G - 1) / G, cst = G;
    if (G == 256) { cst = 1;
        if (early) { cu0 = 256 + 2 * (bid - 128); cn = bid >= 128 ? 2 : 0; }
        else { if (bid >= 192) { cu0 = 3 * (bid - 192); cn = 3; } else if (bid >= 128) { cu0 = 192 + (bid - 128); cn = 1; } else cn = 0; } }
    for (int ck = 0; ck < cn; ++ck) { const int unit = cu0 + ck * cst;
        const int b = unit / (S / 64), t0 = (unit % (S / 64)) * 64;
        const bf16* ubase = u + (size_t)b * S * INW;
        u32x4 ra[6], rg[6];
#pragma unroll
        for (int k = 0; k < 6; ++k) { const int task = min(tid + 512 * k, 94 * 32 - 1), r = task >> 5, c8 = (task & 31) * 8; const int tok = max(t0 - 30 + r, 0);
            const bf16* up = ubase + (size_t)tok * INW + c8; ra[k] = *(const u32x4*)(up + C_A); rg[k] = *(const u32x4*)(up + C_G); }
#pragma unroll
        for (int k = 0; k < 6; ++k) { const int task = min(tid + 512 * k, 94 * 32 - 1), r = task >> 5, c8 = (task & 31) * 8; const float keep = (t0 - 30 + r) >= 0 ? 1.0f : 0.0f;
            float a[8], g[8], h[8]; unpack8(ra[k], a); unpack8(rg[k], g);
#pragma unroll
            for (int t = 0; t < 8; ++t) h[t] = keep * a[t] * __builtin_amdgcn_rcpf(1.0f + __expf(-g[t]));
            *(f32x4*)(hl + r * 256 + c8) = (f32x4){h[0], h[1], h[2], h[3]}; *(f32x4*)(hl + r * 256 + c8 + 4) = (f32x4){h[4], h[5], h[6], h[7]}; }
        __syncthreads();
#pragma unroll 1
        for (int run = 0; run < 2; ++run) {
            const int tb = half * 32 + run * 16;
            float win[46];
#pragma unroll
            for (int i = 0; i < 46; ++i) win[i] = hl[(tb + i) * 256 + c];
#pragma unroll
            for (int tt = 0; tt < 16; ++tt) { float acc = bias;
#pragma unroll
                for (int w = 0; w < 31; ++w) acc = fmaf(W[w], win[tt + w], acc);
                const float ss = wave_sum_dpp(acc * acc); float y = acc * __builtin_amdgcn_rsqf(ss * (1.0f / 64.0f) + EPS) * gain; y = y * __builtin_amdgcn_rcpf(1.0f + __expf(-y));
                mix[(size_t)(b * S + t0 + tb + tt) * D + MX_CONV + c] = (bf16)f2bf(y); }
        }
        __syncthreads();
    }
}
typedef short bf16x8_t __attribute__((ext_vector_type(8)));
typedef float f32x16 __attribute__((ext_vector_type(16)));
typedef short s16x4_t __attribute__((ext_vector_type(4)));
constexpr int A2_TAB = 1376, A2_T1 = 0, A2_T4 = 192, A2_T1A = 576;
constexpr int A2_LDS_V = 33792, A2_LDS_K = A2_LDS_V + 8 * 4096, A2_LDS_OX = A2_LDS_K + 8 * 4096, A2_LDS_LX = A2_LDS_OX + 256 * 64 * 2;
constexpr float LOG2E = 1.4426950408889634f;
__device__ __forceinline__ unsigned cvtpk(float lo, float hi) { typedef float f2 __attribute__((ext_vector_type(2))); typedef __bf16 b2 __attribute__((ext_vector_type(2))); f2 v = {lo, hi}; b2 b = __builtin_convertvector(v, b2); return __builtin_bit_cast(unsigned, b); }
__device__ __forceinline__ void at2_compute(const LAS unsigned char* krd, int ksel, const bf16x8_t (&qf)[4], const float* tp_, int kneg, int hh, unsigned char* vs, int vroff, int tsw, f32x16& o0, f32x16& o1, f32x16& lacc) {
    f32x16 s;
#pragma unroll
    for (int i = 0; i < 16; ++i) s[i] = 0.f;
#pragma unroll
    for (int t = 0; t < 4; ++t) s = __builtin_amdgcn_mfma_f32_32x32x16_bf16(*(const LAS bf16x8_t*)(krd + (((2 * t) ^ ksel) * 16)), qf[t], s, 0, 0, 0);
    float pe[16];
#pragma unroll
    for (int i = 0; i < 16; ++i) pe[i] = __builtin_amdgcn_exp2f(fmaf(s[i], LOG2E, tp_[(i & 3) + 8 * (i >> 2)]));
    if (kneg > 0) {
        asm volatile("" ::: "memory");
#pragma unroll
        for (int i = 0; i < 16; ++i) if ((i & 3) + 8 * (i >> 2) + 4 * hh < kneg) pe[i] = 0.f; }
    bf16x8_t pf[2];
#pragma unroll
    for (int sx = 0; sx < 2; ++sx) { u32x4 w; w.x = cvtpk(pe[8 * sx + 0], pe[8 * sx + 1]); w.y = cvtpk(pe[8 * sx + 2], pe[8 * sx + 3]); w.z = cvtpk(pe[8 * sx + 4], pe[8 * sx + 5]); w.w = cvtpk(pe[8 * sx + 6], pe[8 * sx + 7]); pf[sx] = __builtin_bit_cast(bf16x8_t, w); }
    const bf16x8_t ones = (bf16x8_t){0x3F80, 0x3F80, 0x3F80, 0x3F80, 0x3F80, 0x3F80, 0x3F80, 0x3F80};
#pragma unroll
    for (int sx = 0; sx < 2; ++sx) {
        lacc = __builtin_amdgcn_mfma_f32_32x32x16_bf16(pf[sx], ones, lacc, 0, 0, 0);
#pragma unroll
        for (int db = 0; db < 2; ++db) {
            const LAS unsigned char* va = (const LAS unsigned char*)vs + vroff + sx * 2048 + ((db ^ tsw) * 64);
            const s16x4_t lo = __builtin_bit_cast(s16x4_t, __builtin_amdgcn_ds_read_tr16_b64_v4i16((LAS s16x4_t*)va));
            const s16x4_t hi = __builtin_bit_cast(s16x4_t, __builtin_amdgcn_ds_read_tr16_b64_v4i16((LAS s16x4_t*)(va + 1024)));
            const bf16x8_t vf = (bf16x8_t){lo[0], lo[1], lo[2], lo[3], hi[0], hi[1], hi[2], hi[3]};
            if (db == 0) o0 = __builtin_amdgcn_mfma_f32_32x32x16_bf16(pf[sx], vf, o0, 0, 0, 0); else o1 = __builtin_amdgcn_mfma_f32_32x32x16_bf16(pf[sx], vf, o1, 0, 0, 0); } }
}
__device__ __forceinline__ void ph_attn_tables(const P& p, int bid, int G) {
    const int tid = tid_opaque(); const float* rb = p.in[13]; float* out = (float*)(p.ws + WS_ATAB);
    const int total = DEPTH * 6 * A2_TAB;
    for (int e0 = bid * 512; e0 < total; e0 += G * 512) {
        const int e = e0 + tid; if (e >= total) continue;
        const int l = e / (6 * A2_TAB), r = e % (6 * A2_TAB), hd = r / A2_TAB, x = r % A2_TAB;
        const float* qg = p.in[7] + l * 64; const float* kg = p.in[8] + l * 64;
        float mq = 0.f, mk = 0.f, mb = 0.f;
        for (int c = 0; c < 64; ++c) { mq = fmaxf(mq, fabsf(qg[c])); mk = fmaxf(mk, fabsf(kg[c])); }
        for (int c = 0; c < 192; ++c) mb = fmaxf(mb, rb[c]);
        const float cshift = 8.0f * mq * mk + mb;
        int dl, dist;
        if (x < A2_T4) { dl = 16; dist = 128 - (x - 31); } else if (x < A2_T1A) { dl = 4; dist = 128 - (x - A2_T4 - 124); } else { const int z = x - A2_T1A; dl = 1; dist = 128 + 16 * (z / 200) - (z % 200 - 7); }
        float v = -1e30f;
        if (dist >= 0 && dist <= 128) { const int n = dist * dl; int bucket;
            if (n < 16) bucket = n; else { const float nf = (float)n; const int lg = 16 + (int)(logf(nf / 16.0f) / 4.852030263919617f * 16.0f); bucket = lg < 31 ? lg : 31; }
            v = (rb[bucket * 6 + hd] - cshift) * LOG2E; }
        out[e] = v; }
}
__device__ __forceinline__ void ph_attn(const P& p, int layer, unsigned char* lds, int bid, int G) {
    const int tid = tid_opaque(), lane = tid & 63, wave = __builtin_amdgcn_readfirstlane(tid >> 6);
    float* tab = (float*)lds;
    {   const f32x4* src = (const f32x4*)(p.ws + WS_ATAB) + (size_t)layer * (6 * A2_TAB / 4);
        constexpr int NV = 6 * A2_TAB / 4, NI = (NV + 511) / 512; f32x4 tv[NI];
#pragma unroll
        for (int i = 0; i < NI; ++i) tv[i] = src[min(tid + 512 * i, NV - 1)];
#pragma unroll
        for (int i = 0; i < NI; ++i) if (tid + 512 * i < NV) ((f32x4*)tab)[tid + 512 * i] = tv[i]; }
    __syncthreads();
    const bf16* u = (const bf16*)(p.ws + WS_U); bf16* mix = (bf16*)(p.ws + WS_MIX);
    unsigned char* vs = lds + A2_LDS_V + wave * 4096; unsigned char* ksw = lds + A2_LDS_K + wave * 4096; bf16* Ox = (bf16*)(lds + A2_LDS_OX); float* lx = (float*)(lds + A2_LDS_LX);
    const int r32 = lane & 31, hh = lane >> 5;
    const int vrow = lane >> 3, vch = lane & 7;
    const int vwoff = vrow * 128 + ((vch ^ (((vrow >> 1) & 1) << 2)) * 16);
    const int tq = (lane & 15) >> 2, tp = lane & 3, tsw = (tq >> 1) & 1;
    const int vroff = (4 * hh + tq) * 128 + (2 * ((lane >> 4) & 1) + (tp >> 1)) * 16 + (tp & 1) * 8;
    const int kwoff = vrow * 128 + ((vch ^ vrow) * 16);
    const int ksel = hh ^ (r32 & 7);
    const LAS unsigned char* krd = (const LAS unsigned char*)ksw + r32 * 128;
#define A2_UNIT(BU, HALF, SP, HD, B) do { if (G == 256) { const int xcd_ = bid & 7, slot_ = bid >> 3, k_ = (BU) >> 8, bh_ = 4 * k_ + (xcd_ >> 1); HALF = slot_ & 1; SP = 16 * (xcd_ & 1) + (slot_ >> 1); HD = bh_ % 6; B = bh_ / 6; } \
        else { HALF = (BU) & 1; SP = ((BU) >> 1) & 31; HD = ((BU) >> 6) % 6; B = (BU) / 384; } } while (0)
    const int rot = (4 * wave) % 6;
#define A2_KT(T) (((T) + rot) % 6)
#define A2_PREF_A(UBN, BASEN) do { const int pkb_ = (BASEN) - 128 + 32 * A2_KT(0); \
        _Pragma("unroll") for (int it_ = 0; it_ < 4; ++it_) kA[it_] = *(const u32x4*)((const char*)(UBN) + (unsigned)(min(max(pkb_ + vrow + 8 * it_, 0), S - 1) * (INW * 2) + (C_AK + 8 * vch) * 2)); \
        _Pragma("unroll") for (int it_ = 0; it_ < 4; ++it_) vA[it_] = *(const u32x4*)((const char*)(UBN) + (unsigned)(min(max(pkb_ + vrow + 8 * it_, 0), S - 1) * (INW * 2) + (C_AV + 8 * vch) * 2)); \
        { const bf16* qp_ = (UBN) + (size_t)((BASEN) + 16 * (r32 >> 3) + (r32 & 7)) * INW + C_AQ + 8 * hh; \
          _Pragma("unroll") for (int t_ = 0; t_ < 4; ++t_) qfa[t_] = *(const bf16x8_t*)(qp_ + 16 * t_); } } while (0)
    u32x4 kA[4], kB[4], vA[4], vB[4];
    bf16x8_t qfa[4], qfb[4];
    int half = 0, sp = 0, hd = 0, b = 0;
    if (bid < 768) { A2_UNIT(bid, half, sp, hd, b); A2_PREF_A(u + (size_t)b * S * INW + hd * 64, sp * 512 + 64 * wave + 8 * half); }
    for (int bu = bid; bu < 768; bu += G) {
        if (wave >= 4) __builtin_amdgcn_s_sleep(24);
        const int p0 = sp * 512, rr0 = 8 * half;
        const bf16* ub = u + (size_t)b * S * INW + hd * 64;
        const float* tbh = tab + hd * A2_TAB;
        f32x16 o0, o1, lacc;
#pragma unroll
        for (int i = 0; i < 16; ++i) { o0[i] = 0.f; o1[i] = 0.f; lacc[i] = 0.f; }
        const int rr = rr0 + wave;
        const int k1 = max(0, 4 - p0 / 512), k4b = max(0, 4 - p0 / 128), k4 = k4b - ((k4b > 0 && rr >= 4) ? 1 : 0);
        const int n1 = 5 - k1, NT = n1 + 8 - k4;
        int d_pkb, d_tb, d_kneg, d_dls;
        { const int t = min(lane, NT - 1);
          if (t < n1) { const int kt = k1 + t; d_dls = 4; d_pkb = p0 + rr - 2048 + 512 * kt; d_tb = A2_T1 + 31 + 32 * kt; }
          else { const int kt = k4 + t - n1; d_dls = 2; d_pkb = p0 + rr - 512 + 128 * kt; d_tb = A2_T4 + 124 + 32 * kt; }
          d_kneg = lane >= NT ? 32 : (d_pkb < 0 ? ((-d_pkb + (1 << d_dls) - 1) >> d_dls) : 0); }
#define A2_ISSUE_B(F, KR, VR) do { const int pkb_ = __builtin_amdgcn_readlane(d_pkb, (F)), dls_ = __builtin_amdgcn_readlane(d_dls, (F)); \
                _Pragma("unroll") for (int it_ = 0; it_ < 4; ++it_) KR[it_] = *(const u32x4*)((const char*)ub + (unsigned)(min(max(pkb_ + ((vrow + 8 * it_) << dls_), 0), S - 1) * (INW * 2) + (C_AK + 8 * vch) * 2)); \
                _Pragma("unroll") for (int it_ = 0; it_ < 4; ++it_) VR[it_] = *(const u32x4*)((const char*)ub + (unsigned)(min(max(pkb_ + ((vrow + 8 * it_) << dls_), 0), S - 1) * (INW * 2) + (C_AV + 8 * vch) * 2)); } while (0)
        {   const int base = p0 + 64 * wave + rr0;
            const float* tpa = tbh + A2_T1A + (r32 >> 3) * 200 + 7 - (r32 & 7) + 4 * hh;
#define A2_ISSUE_A(T, KR, VR) do { const int pkb_ = base - 128 + 32 * A2_KT(T); \
                _Pragma("unroll") for (int it_ = 0; it_ < 4; ++it_) KR[it_] = *(const u32x4*)((const char*)ub + (unsigned)(min(max(pkb_ + vrow + 8 * it_, 0), S - 1) * (INW * 2) + (C_AK + 8 * vch) * 2)); \
                _Pragma("unroll") for (int it_ = 0; it_ < 4; ++it_) VR[it_] = *(const u32x4*)((const char*)ub + (unsigned)(min(max(pkb_ + vrow + 8 * it_, 0), S - 1) * (INW * 2) + (C_AV + 8 * vch) * 2)); } while (0)
#define A2_STEP_A(T, KR, VR, KN, VN) do { \
                _Pragma("unroll") for (int it_ = 0; it_ < 4; ++it_) { *(u32x4*)(vs + vwoff + it_ * 1024) = VR[it_]; *(u32x4*)(ksw + kwoff + it_ * 1024) = KR[it_]; } \
                A2_ISSUE_A((T) + 1, KN, VN); \
                { const int kt_ = A2_KT(T), pkb_ = base - 128 + 32 * kt_; const int kneg_ = min(max(0, -pkb_), 32); \
                  at2_compute(krd, ksel, qfa, tpa + 32 * kt_, kneg_, hh, vs, vroff, tsw, o0, o1, lacc); } } while (0)
#pragma unroll 1
            for (int t = 0; t < 4; t += 2) { A2_STEP_A(t, kA, vA, kB, vB); A2_STEP_A(t + 1, kB, vB, kA, vA); }
            A2_STEP_A(4, kA, vA, kB, vB);
            { _Pragma("unroll") for (int it_ = 0; it_ < 4; ++it_) { *(u32x4*)(vs + vwoff + it_ * 1024) = vB[it_]; *(u32x4*)(ksw + kwoff + it_ * 1024) = kB[it_]; }
              A2_ISSUE_B(0, kA, vA);
              { const bf16* qp = ub + (size_t)(p0 + rr + 16 * r32) * INW + C_AQ + 8 * hh;
                _Pragma("unroll") for (int t = 0; t < 4; ++t) qfb[t] = *(const bf16x8_t*)(qp + 16 * t); }
              const int kt_ = A2_KT(5), pkb_ = base - 128 + 32 * kt_; at2_compute(krd, ksel, qfa, tpa + 32 * kt_, min(max(0, -pkb_), 32), hh, vs, vroff, tsw, o0, o1, lacc); }
#undef A2_ISSUE_A
#undef A2_STEP_A
            bf16* oxw = Ox + (32 * wave + 4 * hh) * 64 + r32; float* lxw = lx + 32 * wave + 4 * hh;
#pragma unroll
            for (int i = 0; i < 16; ++i) { const int ci = (i & 3) + 8 * (i >> 2); oxw[ci * 64] = (bf16)f2bf(o0[i]); oxw[ci * 64 + 32] = (bf16)f2bf(o1[i]); if (r32 == 0) lxw[ci] = lacc[i]; }
        }
        __syncthreads();
        if (wave >= 4) __builtin_amdgcn_s_sleep(24);
        int half_n, sp_n, hd_n, b_n;
        {   const bf16* oxr = Ox + (32 * hh + wave) * 64 + r32; const float* lxr = lx + 32 * hh + wave;
#pragma unroll
            for (int i = 0; i < 16; ++i) { const int ci = 8 * ((i & 3) + 8 * (i >> 2)); o0[i] = bf_lo((unsigned)oxr[ci * 64]); o1[i] = bf_lo((unsigned)oxr[ci * 64 + 32]); lacc[i] = lxr[ci]; }
#define A2_STEP_B(F, KR, VR, KN, VN) do { \
                _Pragma("unroll") for (int it_ = 0; it_ < 4; ++it_) { *(u32x4*)(vs + vwoff + it_ * 1024) = VR[it_]; *(u32x4*)(ksw + kwoff + it_ * 1024) = KR[it_]; } \
                A2_ISSUE_B((F) + 1, KN, VN); \
                { const int tb_ = __builtin_amdgcn_readlane(d_tb, (F)), kneg_ = __builtin_amdgcn_readlane(d_kneg, (F)), dls_ = __builtin_amdgcn_readlane(d_dls, (F)); \
                  at2_compute(krd, ksel, qfb, tbh + tb_ - (r32 << (4 - dls_)) + 4 * hh, kneg_, hh, vs, vroff, tsw, o0, o1, lacc); } } while (0)
            int f = 0;
            for (; f + 1 < NT; f += 2) { A2_STEP_B(f, kA, vA, kB, vB); A2_STEP_B(f + 1, kB, vB, kA, vA); }
            const bool odd = f < NT;
            if (odd) { _Pragma("unroll") for (int it_ = 0; it_ < 4; ++it_) { *(u32x4*)(vs + vwoff + it_ * 1024) = vA[it_]; *(u32x4*)(ksw + kwoff + it_ * 1024) = kA[it_]; } }
            { const int bn = bu + G < 768 ? bu + G : bu; A2_UNIT(bn, half_n, sp_n, hd_n, b_n);
              A2_PREF_A(u + (size_t)b_n * S * INW + hd_n * 64, sp_n * 512 + 64 * wave + 8 * half_n); }
            if (odd) {
                const int tb_ = __builtin_amdgcn_readlane(d_tb, f), kneg_ = __builtin_amdgcn_readlane(d_kneg, f), dls_ = __builtin_amdgcn_readlane(d_dls, f);
                at2_compute(krd, ksel, qfb, tbh + tb_ - (r32 << (4 - dls_)) + 4 * hh, kneg_, hh, vs, vroff, tsw, o0, o1, lacc); }
#undef A2_STEP_B
            bf16* ot = (bf16*)ksw;
#pragma unroll
            for (int i = 0; i < 16; ++i) { const int qi = (i & 3) + 8 * (i >> 2) + 4 * hh; const float il = __builtin_amdgcn_rcpf(lacc[i]);
                ot[qi * 64 + r32] = (bf16)f2bf(o0[i] * il); ot[qi * 64 + 32 + r32] = (bf16)f2bf(o1[i] * il); }
            { const int orow = lane >> 1, oh = lane & 1; const u32x4* os = (const u32x4*)(ot + orow * 64 + 32 * oh);
              u32x4* og = (u32x4*)(mix + ((size_t)b * S + p0 + rr + 16 * orow) * D + MX_ATT + hd * 64 + 32 * oh);
#pragma unroll
              for (int k = 0; k < 4; ++k) og[k] = os[k]; }
        }
#undef A2_ISSUE_B
        __syncthreads();
        half = half_n; sp = sp_n; hd = hd_n; b = b_n;
    }
#undef A2_PREF_A
#undef A2_KT
#undef A2_UNIT
    __syncthreads();
}
__device__ __forceinline__ bf16x8_t tr2(const LAS unsigned char* a, int second) {
    const s16x4_t lo = __builtin_bit_cast(s16x4_t, __builtin_amdgcn_ds_read_tr16_b64_v4i16((LAS s16x4_t*)a));
    const s16x4_t hi = __builtin_bit_cast(s16x4_t, __builtin_amdgcn_ds_read_tr16_b64_v4i16((LAS s16x4_t*)(a + second)));
    return (bf16x8_t){lo[0], lo[1], lo[2], lo[3], hi[0], hi[1], hi[2], hi[3]}; }
__device__ __forceinline__ void ph_retI(const P& p, unsigned char* lds, int bid_, int G) {
    const int bid = sgpr_opaque(bid_);
    const int tid = tid_opaque(), lane = tid & 63, wave = __builtin_amdgcn_readfirstlane(tid >> 6), r32 = lane & 31, hh = lane >> 5;
    const bf16* u = (const bf16*)(p.ws + WS_U); float* Pb = (float*)(p.ws + WS_KV); float* Xb = (float*)(p.ws + WS_ST);
    unsigned char* ks = lds + wave * 16384; unsigned char* vs = ks + 8192;
    const int troff = (8 * hh + ((lane & 15) >> 2)) * 64 + (16 * ((lane >> 4) & 1) + 4 * (lane & 3)) * 2;
    for (int unit = bid; unit < 384; unit += G) {
        int db, run, bh;
        if (G == 256) { const int x = bid & 7, j = (unit >> 8) * 32 + (bid >> 3), grp = x * 12 + (j >> 2), bhp = grp >> 4; db = j & 1; run = grp & 15; bh = (bhp / 3) * 6 + 2 * (bhp % 3) + ((j >> 1) & 1); }
        else { db = unit & 1; run = (unit >> 1) & 15; bh = unit >> 5; }
        const int b = bh / 6, h = bh % 6, n = run * 8 + wave;
        const float g128 = exp2f(128.0f * gamma_log2(h));
        const bf16* ukb = u + ((size_t)b * S + n * 128) * INW + C_RK + h * 32; const bf16* uvb = u + ((size_t)b * S + n * 128) * INW + C_RV + h * 64 + db * 32;
        u32x4 kr[8], vr[8];
#pragma unroll
        for (int it = 0; it < 8; ++it) { const int c = lane + 64 * it, row = c >> 2, ch = c & 3; kr[it] = *(const u32x4*)(ukb + (size_t)row * INW + ch * 8); vr[it] = *(const u32x4*)(uvb + (size_t)row * INW + ch * 8); }
#pragma unroll
        for (int it = 0; it < 8; ++it) { const int c = lane + 64 * it; *(u32x4*)(ks + c * 16) = kr[it]; *(u32x4*)(vs + c * 16) = vr[it]; }
        f32x16 dW;
#pragma unroll
        for (int i = 0; i < 16; ++i) dW[i] = 0.f;
#pragma unroll
        for (int s = 0; s < 8; ++s) { const bf16x8_t af = tr2((const LAS unsigned char*)ks + troff + s * 1024, 256), bfv = tr2((const LAS unsigned char*)vs + troff + s * 1024, 256);
            dW = __builtin_amdgcn_mfma_f32_32x32x16_bf16(af, bfv, dW, 0, 0, 0); }
        float* xw = (float*)ks;
#pragma unroll
        for (int i = 0; i < 16; ++i) xw[i * 64 + lane] = dW[i];
        __syncthreads();
        f32x16 X;
#pragma unroll
        for (int i = 0; i < 16; ++i) X[i] = 0.f;
        float cf = g128;
        for (int j = wave - 1; j >= 0; --j) { const float* xr = (const float*)(lds + j * 16384);
#pragma unroll
            for (int i = 0; i < 16; ++i) X[i] += cf * xr[i * 64 + lane];
            cf *= g128; }
        { float* Pp = Pb + ((size_t)(bh * 128 + n) * 64 + db * 32 + r32) * 32 + 4 * hh;
#pragma unroll
          for (int g = 0; g < 4; ++g) *(f32x4*)(Pp + 8 * g) = (f32x4){X[4 * g], X[4 * g + 1], X[4 * g + 2], X[4 * g + 3]}; }
        if (wave == 7) {
            float* Xp = Xb + ((size_t)(bh * 16 + run) * 64 + db * 32 + r32) * 32 + 4 * hh;
#pragma unroll
            for (int g = 0; g < 4; ++g) *(f32x4*)(Xp + 8 * g) = (f32x4){g128 * (X[4 * g] + dW[4 * g]), g128 * (X[4 * g + 1] + dW[4 * g + 1]), g128 * (X[4 * g + 2] + dW[4 * g + 2]), g128 * (X[4 * g + 3] + dW[4 * g + 3])}; }
        __syncthreads();
    }
    __syncthreads();
}
constexpr int R2_WST = 0, R2_WAVE = 8192, R2_WSTRIDE = 16384;
__device__ __forceinline__ void ph_retII(const P& p, int layer, unsigned char* lds, int bid, int G) {
    const int tid = tid_opaque(), lane = tid & 63, wave = __builtin_amdgcn_readfirstlane(tid >> 6), r32 = lane & 31, hh = lane >> 5;
    const bf16* u = (const bf16*)(p.ws + WS_U); bf16* mix = (bf16*)(p.ws + WS_MIX); const float* Pb = (const float*)(p.ws + WS_KV); const float* Xb = (const float*)(p.ws + WS_ST);
    const float* retg = p.in[6] + layer * 384;
    float* wst = (float*)(lds + R2_WST);
    unsigned char* vs = lds + R2_WAVE + wave * R2_WSTRIDE;
    const int vrow = lane >> 3, vch = lane & 7, vwoff = vrow * 128 + ((vch ^ (((vrow >> 1) & 1) << 2)) * 16);
    const int tq = (lane & 15) >> 2, tp = lane & 3, tsw = (tq >> 1) & 1;
    const int vroff = (4 * hh + tq) * 128 + (2 * ((lane >> 4) & 1) + (tp >> 1)) * 16 + (tp & 1) * 8;
    const int erow = lane >> 1, eh16 = lane & 1;
    for (int bu = bid; bu < 192; bu += G) {
        int bh, run;
        if (G == 256) { const int x = bid & 7, slot = bid >> 3, grp = x * 12 + (slot >> 1), bhp = grp >> 4; run = grp & 15; bh = (bhp / 3) * 6 + 2 * (bhp % 3) + (slot & 1); }
        else { bh = bu >> 4; run = bu & 15; }
        const int b = bh / 6, h = bh % 6, n = run * 8 + wave; const size_t row0 = (size_t)b * S + n * 128; const float l2g = gamma_log2(h);
        const bf16* ub = u + row0 * INW;
        u32x4 vr[16];
#pragma unroll
        for (int it = 0; it < 16; ++it) { const int c = lane + 64 * it; vr[it] = *(const u32x4*)(ub + (size_t)(c >> 3) * INW + C_RV + h * 64 + (c & 7) * 8); }
        bf16x8_t qn[2], kf[4][2];
#pragma unroll
        for (int q = 0; q < 4; ++q) { const bf16* rp = ub + (size_t)(32 * q + r32) * INW + h * 32 + 8 * hh; kf[q][0] = *(const bf16x8_t*)(rp + C_RK); kf[q][1] = *(const bf16x8_t*)(rp + C_RK + 16); }
        { const bf16* rp = ub + (size_t)r32 * INW + h * 32 + 8 * hh + C_RQ; qn[0] = *(const bf16x8_t*)rp; qn[1] = *(const bf16x8_t*)(rp + 16); }
        f32x4 pr[2][2][2];
        { const float* Pp = Pb + ((size_t)(bh * 128 + n) * 64 + r32) * 32 + 8 * hh;
#pragma unroll
          for (int db = 0; db < 2; ++db)
#pragma unroll
              for (int s = 0; s < 2; ++s) { pr[db][s][0] = *(const f32x4*)(Pp + db * 1024 + 16 * s); pr[db][s][1] = *(const f32x4*)(Pp + db * 1024 + 16 * s + 4); } }
        { const int dim = 8 * wave + (lane >> 3), dk4 = (lane & 7) * 4; f32x4 xr[15];
#pragma unroll
          for (int j = 0; j < 15; ++j) { const int m = max(run - 1 - j, 0); xr[j] = *(const f32x4*)(Xb + ((size_t)(bh * 16 + m) * 64 + dim) * 32 + dk4); }
          f32x4 acc = {0.f, 0.f, 0.f, 0.f}; float cf = 1.0f; const float c1024 = exp2f(1024.0f * l2g);
#pragma unroll
          for (int j = 0; j < 15; ++j) { const float cc = j < run ? cf : 0.0f; acc += cc * xr[j]; cf *= c1024; }
          *(f32x4*)(wst + dim * 32 + dk4) = acc; }
        __syncthreads();
        bf16x8_t wf[2][2];
        { const float g128t = exp2f(128.0f * (float)wave * l2g);
#pragma unroll
          for (int db = 0; db < 2; ++db)
#pragma unroll
              for (int s = 0; s < 2; ++s) { const float* wp = wst + (32 * db + r32) * 32 + 16 * s + 8 * hh; const f32x4 a = pr[db][s][0] + g128t * *(const f32x4*)wp, c4 = pr[db][s][1] + g128t * *(const f32x4*)(wp + 4);
                  u32x4 pk; pk.x = cvtpk(a.x, a.y); pk.y = cvtpk(a.z, a.w); pk.z = cvtpk(c4.x, c4.y); pk.w = cvtpk(c4.z, c4.w); wf[db][s] = __builtin_bit_cast(bf16x8_t, pk); } }
#pragma unroll
        for (int it = 0; it < 12; ++it) *(u32x4*)(vs + (it >> 2) * 4096 + vwoff + (it & 3) * 1024) = vr[it];
#pragma unroll 1
        for (int qt = 0; qt < 4; ++qt) {
            bf16x8_t qc[2]; qc[0] = qn[0]; qc[1] = qn[1];
            { const bf16* rp = ub + (size_t)(32 * min(qt + 1, 3) + r32) * INW + h * 32 + 8 * hh + C_RQ; qn[0] = *(const bf16x8_t*)rp; qn[1] = *(const bf16x8_t*)(rp + 16); }
            const bf16* gp = ub + (size_t)(32 * qt + erow) * INW + C_RG + h * 64 + 16 * eh16; u32x4 gv[4];
            gv[0] = *(const u32x4*)gp; gv[1] = *(const u32x4*)(gp + 8); gv[2] = *(const u32x4*)(gp + 32); gv[3] = *(const u32x4*)(gp + 40);
            if (qt == 3) {
#pragma unroll
                for (int it = 0; it < 4; ++it) *(u32x4*)(vs + 3 * 4096 + vwoff + it * 1024) = vr[12 + it]; }
            f32x16 o0, o1;
#pragma unroll
            for (int i = 0; i < 16; ++i) { o0[i] = 0.f; o1[i] = 0.f; }
            o0 = __builtin_amdgcn_mfma_f32_32x32x16_bf16(qc[0], wf[0][0], o0, 0, 0, 0); o0 = __builtin_amdgcn_mfma_f32_32x32x16_bf16(qc[1], wf[0][1], o0, 0, 0, 0);
            o1 = __builtin_amdgcn_mfma_f32_32x32x16_bf16(qc[0], wf[1][0], o1, 0, 0, 0); o1 = __builtin_amdgcn_mfma_f32_32x32x16_bf16(qc[1], wf[1][1], o1, 0, 0, 0);
#pragma unroll
            for (int kt = 0; kt < 4; ++kt) if (kt <= qt) {
                f32x16 s;
#pragma unroll
                for (int i = 0; i < 16; ++i) s[i] = 0.f;
                s = __builtin_amdgcn_mfma_f32_32x32x16_bf16(kf[kt][0], qc[0], s, 0, 0, 0); s = __builtin_amdgcn_mfma_f32_32x32x16_bf16(kf[kt][1], qc[1], s, 0, 0, 0);
                if (kt == qt) {
#pragma unroll
                    for (int i = 0; i < 16; ++i) if ((i & 3) + 8 * (i >> 2) + 4 * hh > r32) s[i] = 0.f; }
                bf16x8_t pf[2];
#pragma unroll
                for (int sx = 0; sx < 2; ++sx) { u32x4 w4; w4.x = cvtpk(s[8 * sx + 0], s[8 * sx + 1]); w4.y = cvtpk(s[8 * sx + 2], s[8 * sx + 3]); w4.z = cvtpk(s[8 * sx + 4], s[8 * sx + 5]); w4.w = cvtpk(s[8 * sx + 6], s[8 * sx + 7]); pf[sx] = __builtin_bit_cast(bf16x8_t, w4); }
#pragma unroll
                for (int sx = 0; sx < 2; ++sx)
#pragma unroll
                    for (int db = 0; db < 2; ++db) { const bf16x8_t vf = tr2((const LAS unsigned char*)vs + kt * 4096 + vroff + sx * 2048 + ((db ^ tsw) * 64), 1024);
                        if (db == 0) o0 = __builtin_amdgcn_mfma_f32_32x32x16_bf16(pf[sx], vf, o0, 0, 0, 0); else o1 = __builtin_amdgcn_mfma_f32_32x32x16_bf16(pf[sx], vf, o1, 0, 0, 0); }
            }
            float* osc = (float*)(vs + (qt == 3 ? 0 : 3 * 4096));
            f32x4 ov[2][4]; float ss = 0.f;
#pragma unroll
            for (int db = 0; db < 2; ++db) {
#pragma unroll
                for (int i = 0; i < 16; ++i) { const int qi = (i & 3) + 8 * (i >> 2) + 4 * hh; osc[qi * 32 + r32] = db == 0 ? o0[i] : o1[i]; }
#pragma unroll
                for (int k = 0; k < 4; ++k) { ov[db][k] = *(const f32x4*)(osc + erow * 32 + 16 * eh16 + 4 * k); ss += (ov[db][k].x * ov[db][k].x + ov[db][k].y * ov[db][k].y) + (ov[db][k].z * ov[db][k].z + ov[db][k].w * ov[db][k].w); } }
            ss += __shfl_xor(ss, 1);
            const float rs = __builtin_amdgcn_rsqf(ss * (1.0f / 64.0f) + EPS);
            bf16* mp = mix + (row0 + 32 * qt + erow) * D + MX_RET + h * 64 + 16 * eh16; const float* rgp = retg + h * 64 + 16 * eh16;
#pragma unroll
            for (int k = 0; k < 4; ++k) { const int db = k >> 1, c8 = 8 * (k & 1); float g[8], o[8]; unpack8(gv[k], g); const f32x4 ra = *(const f32x4*)(rgp + 32 * db + c8), rb = *(const f32x4*)(rgp + 32 * db + c8 + 4);
                const f32x4 a = ov[db][2 * (k & 1)] * rs * ra, c4 = ov[db][2 * (k & 1) + 1] * rs * rb;
                o[0] = a.x; o[1] = a.y; o[2] = a.z; o[3] = a.w; o[4] = c4.x; o[5] = c4.y; o[6] = c4.z; o[7] = c4.w;
#pragma unroll
                for (int e = 0; e < 8; ++e) o[e] *= g[e] * __builtin_amdgcn_rcpf(1.0f + __expf(-g[e]));
                *(u32x4*)(mp + 32 * db + c8) = pack8(o); }
        }
        __syncthreads();
    }
    __syncthreads();
}
template <int WHICH> __device__ __forceinline__ void ph_gemm(const P& p, int layer, unsigned char* lds, int bid, int G, unsigned* arc = nullptr, const XcdBarrier* xbp = nullptr) {
    unsigned char* wb = p.ws + WS_W + (size_t)layer * W_LAYER; float* ssq = (float*)(p.ws + WS_SSQ); bf16* xb = (bf16*)(p.ws + WS_XB);
    pg8::StaticOrder So;
    LAS float* rtab = (LAS float*)((LAS unsigned char*)lds + (WHICH == 0 ? 139264 : 131072));
    if constexpr (WHICH == 0) { pg8::Gemm g{xb, (const bf16*)(wb + W_IN), M, INW, D, D}; So.init(M, INW, G, bid, (G % 8 == 0) ? 1 : 0, (G == 256) ? arc : nullptr, xbp); rstd_prepass(So, ssq, rtab); EpiInProj E{(bf16*)(p.ws + WS_U), rtab, (const float2*)(p.ws + WS_ROPE), p.in[7] + layer * 64, p.in[8] + layer * 64, 0};
        pg8::gemm_phase<EpiInProj, pg8::StaticOrder, true, true>((LAS unsigned char*)lds, g, So, E); }
    if constexpr (WHICH == 1) { pg8::Gemm g{(const bf16*)(p.ws + WS_MIX), (const bf16*)(wb + W_OUT), M, D, D, D}; So.init(M, D, G, bid); EpiRes E{layer == 0 ? p.in[0] : nullptr, xb, ssq, nullptr};
        pg8::gemm_phase<EpiRes, pg8::StaticOrder, true, true>((LAS unsigned char*)lds, g, So, E); }
    if constexpr (WHICH == 2) { pg8::Gemm g{xb, (const bf16*)(wb + W_F1), M, FF, D, D}; So.init(M, FF, G, bid); rstd_prepass(So, ssq, rtab); EpiNormBf16<1> E{(bf16*)(p.ws + WS_H), rtab, HP, 0};
        pg8::gemm_phase<EpiNormBf16<1>, pg8::StaticOrder, true, true>((LAS unsigned char*)lds, g, So, E); }
    if constexpr (WHICH == 3) { pg8::Gemm g{(const bf16*)(p.ws + WS_H), (const bf16*)(wb + W_F2), M, D, FF, HP}; So.init(M, D, G, bid); EpiRes E{nullptr, xb, ssq, layer + 1 == DEPTH ? p.out : nullptr};
        pg8::gemm_phase<EpiRes, pg8::StaticOrder, true, true>((LAS unsigned char*)lds, g, So, E); }
}


constexpr int CW_BAR = 4096;
constexpr int LDS_BYTES = 147456;
constexpr int LDS_MISC = LDS_BYTES - 256;
#define GRID_SYNC() xcd_barrier(bar)
__global__ void __launch_bounds__(512, 2) k_mega(P p) {
    extern __shared__ __attribute__((aligned(16))) unsigned char lds[];
    cg::grid_group grid = cg::this_grid();
    const int bid = (int)blockIdx.x, G = (int)gridDim.x;
    volatile LAS unsigned* MISC = (volatile LAS unsigned*)((LAS unsigned char*)lds + LDS_MISC);
    if (threadIdx.x < 64) MISC[threadIdx.x] = 0u;
    __syncthreads();
    if (bid == 0) for (int i = threadIdx.x; i < XCD_BAR_WORDS + XB_EV_WORDS * 2 * DEPTH; i += 512) ((unsigned*)(p.ws + WS_CTL))[CW_BAR + i] = 0u;
    ph_wconv(p, lds, bid, G); __syncthreads();
    ph_xprep(p, bid, G);
    ph_attn_tables(p, bid, G);
    grid.sync();
    XcdBarrier bar = xcd_barrier_post((unsigned*)(p.ws + WS_CTL) + CW_BAR, MISC + 8);
    for (int layer = 0; layer < DEPTH; ++layer) {
        unsigned* arr = (unsigned*)(p.ws + WS_CTL) + CW_BAR + XCD_BAR_WORDS + XB_EV_WORDS * (2 * layer);
        unsigned* arc = arr + XB_EV_WORDS;
        ph_gemm<0>(p, layer, lds, bid, G, arc, &bar);
#pragma unroll 1
        for (int cm = 0; cm < sgpr_opaque(2); ++cm) {
            if (cm == 0) { if (G == 256 && bid >= 128) split_wait(arc, (unsigned)G, (unsigned*)(p.ws + WS_CTL) + CW_BAR); }
            else { GRID_SYNC(); ph_retI(p, lds, bid, G); split_arrive(bar, arr); }
            ph_conv(p, layer, lds, bid, G, cm == 0 ? 1 : 0);
        }
        ph_attn(p, layer, lds, bid, G);
        split_wait(arr, (unsigned)G, (unsigned*)(p.ws + WS_CTL) + CW_BAR);
        ph_retII(p, layer, lds, bid, G);
        GRID_SYNC();
        ph_gemm<1>(p, layer, lds, bid, G);
        GRID_SYNC();
        ph_gemm<2>(p, layer, lds, bid, G);
        GRID_SYNC();
        ph_gemm<3>(p, layer, lds, bid, G);
        if (layer + 1 < DEPTH) GRID_SYNC();
    }
}
extern "C" void kernel_launch(void* const* d_in, const int* in_sizes, int n_in, void* d_out, int out_size, void* d_ws, size_t ws_size, hipStream_t stream) {
    static int grid = 0;
    if (grid == 0) {
        if (n_in != 14 || in_sizes[0] != M * D || out_size != M * D || ws_size < WS_END) { fprintf(stderr, "kernel_launch: unexpected shapes (n_in %d, in0 %d, out %d, ws %zu)\n", n_in, n_in > 0 ? in_sizes[0] : -1, out_size, ws_size); grid = -1; return; }
        int dev = 0, cus = 0, per_cu = 0;
        if (hipGetDevice(&dev) != hipSuccess || hipDeviceGetAttribute(&cus, hipDeviceAttributeMultiprocessorCount, dev) != hipSuccess) { fprintf(stderr, "kernel_launch: device query failed\n"); grid = -1; return; }
        if (hipFuncSetAttribute((const void*)k_mega, hipFuncAttributeMaxDynamicSharedMemorySize, LDS_BYTES) != hipSuccess) { fprintf(stderr, "kernel_launch: hipFuncSetAttribute failed\n"); grid = -1; return; }
        if (hipOccupancyMaxActiveBlocksPerMultiprocessor(&per_cu, (const void*)k_mega, 512, LDS_BYTES) != hipSuccess || per_cu < 1) { fprintf(stderr, "kernel_launch: occupancy query says %d blocks per CU\n", per_cu); grid = -1; return; }
        grid = cus;
        fprintf(stderr, "kernel_launch: %d CUs, occupancy %d per CU, grid %d\n", cus, per_cu, grid);
    }
    if (grid < 0) return;
    P p{}; for (int i = 0; i < 14; ++i) p.in[i] = (const float*)d_in[i];
    p.out = (float*)d_out; p.ws = (unsigned char*)d_ws;
    void* args[] = {&p};
    const hipError_t e = hipLaunchCooperativeKernel((const void*)k_mega, dim3(grid), dim3(512), args, LDS_BYTES, stream);
    if (e != hipSuccess) fprintf(stderr, "kernel_launch: cooperative launch failed: %s (grid %d)\n", hipGetErrorString(e), grid);
}
```

```cpp
#include <hip/hip_runtime.h>
#include <hip/hip_cooperative_groups.h>
#include <cstdio>
#include <cstdint>
namespace cg = cooperative_groups;
#define GAS __attribute__((address_space(1)))
#define LAS __attribute__((address_space(3)))
typedef GAS unsigned gu32;
#define XB_TMO      128
#define XB_XCNT(j)  (256  + 64 * (j))
#define XB_XSUB(j)  (1280 + 64 * (j))
#define XB_XGEN(j)  (2304 + 64 * (j))
#define XB_TOP      3328
#define XB_TOPGEN   3392
#define XCD_BAR_WORDS 3456
#define XB_SPIN_CAP (1u << 21)

__device__ __forceinline__ unsigned xb_ld(unsigned* p)              { return __hip_atomic_load(p, __ATOMIC_RELAXED, __HIP_MEMORY_SCOPE_AGENT); }
__device__ __forceinline__ unsigned xb_add(unsigned* p, unsigned v) { return __hip_atomic_fetch_add(p, v, __ATOMIC_RELAXED, __HIP_MEMORY_SCOPE_AGENT); }
__device__ __forceinline__ unsigned xb_xcc_id() { return (unsigned)__builtin_amdgcn_s_getreg((3 << 11) | 20) & 0xFu; }
#define XB_SPIN(cond, bar) do { unsigned _sp = 0; while (cond) { __builtin_amdgcn_s_sleep(1); \
    if ((++_sp & 255u) == 0u) { if (xb_ld(&(bar)[XB_TMO])) break; if (_sp > XB_SPIN_CAP) { atomicAdd(&(bar)[XB_TMO], 1u); break; } } } } while (0)

struct XcdBarrier {
    unsigned* bar; unsigned x;
    volatile LAS unsigned* st;
};

__device__ __forceinline__ XcdBarrier xcd_barrier_post(unsigned* bar, volatile LAS unsigned* st) {
    XcdBarrier b; b.bar = bar; b.x = xb_xcc_id(); b.st = st;
    if (threadIdx.x == 0) (void)xb_add(&bar[XB_XCNT(b.x)], 1u);
    return b;
}
__device__ __forceinline__ void xcd_barrier_complete(unsigned* bar, unsigned x, unsigned& nloc, unsigned& nx) {
    const unsigned G = gridDim.x * gridDim.y * gridDim.z;
    unsigned sum, cnt, mine, sp = 0u;
    for (;;) {
        sum = 0u; cnt = 0u; mine = 0u;
#pragma unroll
        for (unsigned j = 0; j < 16; ++j) { const unsigned c = xb_ld(&bar[XB_XCNT(j)]); sum += c; cnt += (c > 0u) ? 1u : 0u; mine = (j == x) ? c : mine; }
        if (sum == G) break;
        __builtin_amdgcn_s_sleep(1);
        if ((++sp & 255u) == 0u) { if (xb_ld(&bar[XB_TMO])) break; if (sp > XB_SPIN_CAP) { atomicAdd(&bar[XB_TMO], 1u); break; } }
    }
    nloc = mine > 0u ? mine : 1u; nx = cnt > 0u ? cnt : 1u;
}

__device__ __forceinline__ void xcd_barrier(const XcdBarrier& b) {
    asm volatile("s_waitcnt vmcnt(0)" ::: "memory");
    __syncthreads();
    if (threadIdx.x == 0) {
        unsigned* bar = b.bar;
        __builtin_amdgcn_s_waitcnt(0);
        unsigned nloc = b.st[0], nx = b.st[1];
        if (nloc == 0u) { xcd_barrier_complete(bar, b.x, nloc, nx); b.st[0] = nloc; b.st[1] = nx; }
        const unsigned old = xb_add(&bar[XB_XSUB(b.x)], 1u);
        const unsigned gen = old / nloc;
        if (old + 1u == (gen + 1u) * nloc) {
            __builtin_amdgcn_fence(__ATOMIC_RELEASE, "agent");
            asm volatile("s_waitcnt vmcnt(0)" ::: "memory");
            const unsigned og = xb_add(&bar[XB_TOP], 1u);
            const unsigned tg = og / nx;
            if (og + 1u == (tg + 1u) * nx) xb_add(&bar[XB_TOPGEN], 1u);
            else XB_SPIN(xb_ld(&bar[XB_TOPGEN]) == tg, bar);
            __builtin_amdgcn_fence(__ATOMIC_ACQUIRE, "agent");
            xb_add(&bar[XB_XGEN(b.x)], 1u);
            asm volatile("s_waitcnt vmcnt(0)" ::: "memory");
        } else {
            XB_SPIN(xb_ld(&bar[XB_XGEN(b.x)]) == gen, bar);
            __builtin_amdgcn_fence(__ATOMIC_ACQUIRE, "agent");
            asm volatile("s_waitcnt vmcnt(0)" ::: "memory");
        }
    }
    __syncthreads();
}

#define XB_EV_WORDS 1088
__device__ __forceinline__ void split_arrive(const XcdBarrier& b, unsigned* ev) {
    asm volatile("s_waitcnt vmcnt(0)" ::: "memory");
    __syncthreads();
    if (threadIdx.x == 0) {
        unsigned nloc = b.st[0], nx = b.st[1];
        if (nloc == 0u) { xcd_barrier_complete(b.bar, b.x, nloc, nx); b.st[0] = nloc; b.st[1] = nx; }
        const unsigned old = xb_add(&ev[64u * (1u + b.x)], 1u);
        if (old + 1u == nloc) { __builtin_amdgcn_fence(__ATOMIC_RELEASE, "agent"); asm volatile("s_waitcnt vmcnt(0)" ::: "memory"); (void)xb_add(&ev[0], nloc); }
    }
}
__device__ __forceinline__ void split_wait(unsigned* ctr, unsigned G, unsigned* bar) {
    if (threadIdx.x == 0) { XB_SPIN(xb_ld(ctr) < G, bar); __builtin_amdgcn_fence(__ATOMIC_ACQUIRE, "agent"); asm volatile("s_waitcnt vmcnt(0)" ::: "memory"); }
    __syncthreads();
}
namespace pg8 {
constexpr bool BTILED = true;
#define PG8_LAS __attribute__((address_space(3)))
typedef unsigned short bf16_t;
typedef short bf16x8 __attribute__((ext_vector_type(8)));
typedef float f32x4 __attribute__((ext_vector_type(4)));
typedef unsigned u32x4 __attribute__((ext_vector_type(4)));
constexpr int BM = 256, BK = 64, HALF = 128, HTB = HALF * BK * 2  , STAGE_BYTES = 8 * HTB, NXCD = 8, WGM = 8;

__host__ __device__ __forceinline__ int lds_byte(int r, int c) { const int st = (r >> 4) * 2 + (c >> 5), rr = r & 15, cc = c & 31, ob = rr * 64 + cc * 2; return st * 1024 + (ob ^ (((ob >> 9) & 1) << 5)); }
__host__ __device__ __forceinline__ void stage_rc(int b, int& R, int& C) { const int st = b / 1024, sb = b % 1024, swz = sb ^ (((sb >> 9) & 1) << 5); R = (st >> 1) * 16 + swz / 64; C = (st & 1) * 32 + (swz % 64) / 2; }
__host__ __device__ __forceinline__ int perm32(int rho) { const int n = rho >> 4, i = rho & 15; return 8 * (i >> 2) + 4 * n + (i & 3); }

struct Unit { int pm, pn; };
struct Gemm { const bf16_t* A; const bf16_t* Bt; int M, N, K, lda; };

struct StaticOrder {
    int nM, nN, nwg, G, c, convfirst; unsigned* arr; const XcdBarrier* xbp; mutable int ndone;
    __host__ __device__ void init(int M, int N, int G_, int c_, int convfirst_ = 0, unsigned* arr_ = nullptr, const XcdBarrier* xbp_ = nullptr) { nM = M / BM; nN = N / BM; nwg = nM * nN; G = G_; c = c_; convfirst = convfirst_; arr = arr_; xbp = xbp_; ndone = 0; }
    __host__ __device__ bool next(int i, Unit& u) const {
        const long L = (long)i * G + c; if (L >= nwg) return false;
        if (convfirst) {
            const int xcd = (int)(L % NXCD), off = (int)(L / NXCD), per = nM / NXCD;
            if (off < 2 * per) { u.pm = xcd * per + off % per; u.pn = off / per; }
            else { const int o2 = off - 2 * per, gs = WGM * (nN - 2), grp = o2 / gs, w = o2 % gs; u.pm = xcd * per + grp * WGM + w % WGM; u.pn = 2 + w / WGM; }
            return true; }
        int wgid = (int)L; { const int q = nwg / NXCD, r = nwg % NXCD, xcd = wgid % NXCD, off = wgid / NXCD; wgid = (xcd < r ? xcd * (q + 1) : r * (q + 1) + (xcd - r) * q) + off; }
        const int nig = WGM * nN, gid = wgid / nig, fm = gid * WGM, gsz = (nM - fm) < WGM ? (nM - fm) : WGM;
        u.pm = fm + ((wgid % nig) % gsz); u.pn = (wgid % nig) / gsz; return true;
    }
    __device__ __forceinline__ void a_ready(const Unit&) const {}
    __device__ __forceinline__ void done(const Unit&) const { if (arr != nullptr && ndone++ == 0) split_arrive(*xbp, arr); }
};

__device__ __forceinline__ unsigned cvt_pk_bf16(float lo, float hi) { unsigned r; asm volatile("v_cvt_pk_bf16_f32 %0, %1, %2" : "=v"(r) : "v"(lo), "v"(hi)); return r; }
typedef float f32x2 __attribute__((ext_vector_type(2)));
template <class Epi, class Sched, bool ALIGN_EPI = false, bool SP2 = false, bool ATILED = false  >
__device__ __forceinline__ void gemm_phase(PG8_LAS unsigned char* lds, const Gemm g, const Sched& S, const Epi& E) {
    int tid_ = threadIdx.x; asm volatile("" : "+v"(tid_)); const int tid = tid_, wid = __builtin_amdgcn_readfirstlane(tid >> 6), lane = tid & 63, wr = wid >> 2, wc = wid & 3, fr = lane & 15, fq = lane >> 4;
    const int K = g.K, nt = K / BK;
    unsigned voffA[2], voffB[2];
#pragma unroll
    for (int i = 0; i < 2; ++i) { int R, C; stage_rc(tid * 16 + i * 8192, R, C); const int Rb = Epi::PERM ? (2 * (R & ~31) + perm32(R & 31)) : R;
        voffA[i] = (unsigned)(R * g.lda + C) * 2u; voffB[i] = BTILED ? (unsigned)(Rb * BK + C) * 2u : (unsigned)(Rb * K + C) * 2u; }
    const size_t kstep = (size_t)(BK * 2);
    const size_t hstep = (size_t)HALF * g.lda * 2;
    const size_t kstepA = ATILED ? (size_t)BM * BK * 2 : kstep;
    const size_t tstep = ATILED ? (size_t)(K / BK) * BM * BK * 2 : 2 * hstep, tstepB = (size_t)BM * K * 2;
    const size_t kstepB = BTILED ? (size_t)BM * BK * 2 : kstep;
    const size_t hstepB = BTILED ? (Epi::PERM ? (size_t)32 * BK * 2 : (size_t)HALF * BK * 2) : (Epi::PERM ? (size_t)32 * K * 2 : (size_t)HALF * K * 2);
    const unsigned ldsw = (unsigned)wid * 1024u;
    const int aoff = lds_byte(wr * 64 + fr, fq * 8), boff = lds_byte(wc * 32 + fr, fq * 8);
#define PG8_SA(b, h) (((b) * 2 + (h)) * HTB)
#define PG8_SB(b, h) ((4 + (b) * 2 + (h)) * HTB)
#define PG8_STAGE(bufoff, gbase, voff) do { _Pragma("unroll") for (int _i = 0; _i < 2; ++_i) \
        __builtin_amdgcn_global_load_lds((const unsigned*)((const char*)(gbase) + (voff)[_i]), (PG8_LAS unsigned*)(lds + (bufoff) + ldsw + _i * 8192), 16, 0, 0); } while (0)
#define PG8_LDA(dst, b, h) do { _Pragma("unroll") for (int m = 0; m < 4; ++m) _Pragma("unroll") for (int k = 0; k < 2; ++k) dst[m][k] = *(const PG8_LAS bf16x8*)(lds + PG8_SA(b, h) + aoff + m * 2048 + k * 1024); } while (0)
#define PG8_LDB(dst, b, h) do { _Pragma("unroll") for (int n = 0; n < 2; ++n) _Pragma("unroll") for (int k = 0; k < 2; ++k) dst[n][k] = *(const PG8_LAS bf16x8*)(lds + PG8_SB(b, h) + boff + n * 2048 + k * 1024); } while (0)
#define PG8_MMA(ai, bj, At, Bt) do { __builtin_amdgcn_s_setprio(1); _Pragma("unroll") for (int m = 0; m < 4; ++m) _Pragma("unroll") for (int n = 0; n < 2; ++n) _Pragma("unroll") for (int k = 0; k < 2; ++k) \
        acc[ai][bj][m][n] = __builtin_amdgcn_mfma_f32_16x16x32_bf16(Bt[n][k], At[m][k], acc[ai][bj][m][n], 0, 0, 0); __builtin_amdgcn_s_setprio(0); } while (0)
#define PG8_WAIT_V(n) asm volatile("s_waitcnt vmcnt(" #n ")" ::: "memory")
#define PG8_WAIT_L(n) asm volatile("s_waitcnt lgkmcnt(" #n ")" ::: "memory")
#define PG8_BAR __builtin_amdgcn_s_barrier()
#define PG8_SCHED __builtin_amdgcn_sched_barrier(0)
    Unit cur, nxt; int ui = 0;
    if (!S.next(0, cur)) return;
    f32x4 acc[2][2][4][2];
#pragma unroll
    for (int a = 0; a < 2; ++a)
#pragma unroll
        for (int b = 0; b < 2; ++b)
#pragma unroll
            for (int m = 0; m < 4; ++m)
#pragma unroll
                for (int n = 0; n < 2; ++n) acc[a][b][m][n] = (f32x4){0.f, 0.f, 0.f, 0.f};
    bf16x8 At[4][2], B0[2][2], B1[2][2];
    const char* cA = (const char*)g.A + (size_t)cur.pm * tstep; const char* cB = (const char*)g.Bt + (size_t)cur.pn * tstepB;
    S.a_ready(cur);
    if constexpr (SP2) {
        PG8_STAGE(PG8_SB(0, 0), cB, voffB); PG8_STAGE(PG8_SB(0, 1), cB + hstepB, voffB); PG8_STAGE(PG8_SA(0, 0), cA, voffA); PG8_STAGE(PG8_SA(0, 1), cA + hstep, voffA);
        if (wr == 1) PG8_BAR;
        PG8_WAIT_V(2); PG8_BAR;
        PG8_STAGE(PG8_SB(1, 0), cB + kstepB, voffB); PG8_STAGE(PG8_SA(1, 0), cA + kstepA, voffA); PG8_STAGE(PG8_SB(1, 1), cB + hstepB + kstepB, voffB);
        PG8_WAIT_V(6); PG8_BAR;
    } else {
        PG8_STAGE(PG8_SB(0, 0), cB, voffB); PG8_STAGE(PG8_SA(0, 0), cA, voffA); PG8_STAGE(PG8_SB(0, 1), cB + hstepB, voffB); PG8_STAGE(PG8_SA(0, 1), cA + hstep, voffA);
        if (wr == 1) PG8_BAR;
        PG8_WAIT_V(4); PG8_BAR;
        PG8_STAGE(PG8_SB(1, 0), cB + kstepB, voffB); PG8_STAGE(PG8_SA(1, 0), cA + kstepA, voffA); PG8_STAGE(PG8_SB(1, 1), cB + hstepB + kstepB, voffB);
        PG8_WAIT_V(6); PG8_BAR;
    }
    for (;;) {
        const bool has_next = S.next(ui + 1, nxt);
        const char* nA = has_next ? (const char*)g.A + (size_t)nxt.pm * tstep : cA; const char* nB = has_next ? (const char*)g.Bt + (size_t)nxt.pn * tstepB : cB;
        for (int t = 0; t < nt; t += 2) {
            asm volatile(".p2align 6");
            const bool last = (t == nt - 2);
            const char* a1 = cA + (size_t)(t + 1) * kstepA;
            const char* a2 = last ? nA : cA + (size_t)(t + 2) * kstepA; const char* b2 = last ? nB : cB + (size_t)(t + 2) * kstepB;
            const char* a3 = a2 + kstepA; const char* b3 = b2 + kstepB;
            if (last && has_next) S.a_ready(nxt);
            if constexpr (SP2) {
            PG8_LDB(B0, 0, 0); PG8_LDB(B1, 0, 1); PG8_SCHED; PG8_LDA(At, 0, 0); PG8_STAGE(PG8_SA(1, 1), a1 + hstep, voffA);
            PG8_WAIT_V(8); PG8_WAIT_L(0); PG8_BAR; PG8_MMA(0, 0, At, B0); PG8_MMA(0, 1, At, B1); PG8_BAR; PG8_SCHED;
            PG8_LDA(At, 0, 1); PG8_STAGE(PG8_SB(0, 0), b2, voffB); PG8_STAGE(PG8_SB(0, 1), b2 + hstepB, voffB); PG8_STAGE(PG8_SA(0, 0), a2, voffA);
            PG8_WAIT_V(8); PG8_WAIT_L(0); PG8_BAR; PG8_MMA(1, 0, At, B0); PG8_MMA(1, 1, At, B1); PG8_BAR; PG8_SCHED;
            PG8_LDB(B0, 1, 0); PG8_LDB(B1, 1, 1); PG8_SCHED; PG8_LDA(At, 1, 0); PG8_STAGE(PG8_SA(0, 1), a2 + hstep, voffA);
            PG8_WAIT_V(8); PG8_WAIT_L(0); PG8_BAR; PG8_MMA(0, 0, At, B0); PG8_MMA(0, 1, At, B1); PG8_BAR; PG8_SCHED;
            PG8_LDA(At, 1, 1); PG8_STAGE(PG8_SB(1, 0), b3, voffB); PG8_STAGE(PG8_SB(1, 1), b3 + hstepB, voffB); PG8_STAGE(PG8_SA(1, 0), a3, voffA);
            PG8_WAIT_V(8); PG8_WAIT_L(0); PG8_BAR; PG8_MMA(1, 0, At, B0); PG8_MMA(1, 1, At, B1); PG8_BAR; PG8_SCHED;
            } else {
            PG8_LDB(B0, 0, 0); PG8_SCHED; PG8_LDA(At, 0, 0); PG8_STAGE(PG8_SA(1, 1), a1 + hstep, voffA);
            PG8_WAIT_L(8); PG8_BAR; PG8_WAIT_L(0); PG8_MMA(0, 0, At, B0); PG8_BAR; PG8_SCHED;
            PG8_LDB(B1, 0, 1); PG8_STAGE(PG8_SB(0, 0), b2, voffB);
            PG8_BAR; PG8_WAIT_L(0); PG8_MMA(0, 1, At, B1); PG8_BAR;
            PG8_LDA(At, 0, 1); PG8_STAGE(PG8_SA(0, 0), a2, voffA);
            PG8_BAR; PG8_WAIT_L(0); PG8_MMA(1, 0, At, B0); PG8_BAR; PG8_SCHED;
            PG8_STAGE(PG8_SB(0, 1), b2 + hstepB, voffB);
            PG8_WAIT_V(6); PG8_BAR; PG8_MMA(1, 1, At, B1); PG8_BAR;
            PG8_LDB(B0, 1, 0); PG8_SCHED; PG8_LDA(At, 1, 0); PG8_STAGE(PG8_SA(0, 1), a2 + hstep, voffA);
            PG8_WAIT_L(8); PG8_BAR; PG8_WAIT_L(0); PG8_MMA(0, 0, At, B0); PG8_BAR; PG8_SCHED;
            PG8_LDB(B1, 1, 1); PG8_STAGE(PG8_SB(1, 0), b3, voffB);
            PG8_BAR; PG8_WAIT_L(0); PG8_MMA(0, 1, At, B1); PG8_BAR;
            PG8_LDA(At, 1, 1); PG8_STAGE(PG8_SA(1, 0), a3, voffA);
            PG8_BAR; PG8_WAIT_L(0); PG8_MMA(1, 0, At, B0); PG8_BAR; PG8_SCHED;
            PG8_STAGE(PG8_SB(1, 1), b3 + hstepB, voffB);
            PG8_WAIT_V(6); PG8_BAR; PG8_MMA(1, 1, At, B1); PG8_BAR;
            }
        }
        if constexpr (ALIGN_EPI) { if (wr == 0) PG8_BAR; }
        if constexpr (!Epi::AFTER_DRAIN) { int fr_ = fr, fq_ = fq; asm volatile("" : "+v"(fr_), "+v"(fq_));
            E(acc, cur, wr, wc, fr_, fq_, !has_next  ); S.done(cur); }
        if (!has_next) break;
#pragma unroll
        for (int a = 0; a < 2; ++a)
#pragma unroll
            for (int b = 0; b < 2; ++b)
#pragma unroll
                for (int m = 0; m < 4; ++m)
#pragma unroll
                    for (int n = 0; n < 2; ++n) acc[a][b][m][n] = (f32x4){0.f, 0.f, 0.f, 0.f};
        cur = nxt; cA = nA; cB = nB; ++ui;
        if constexpr (ALIGN_EPI) { if (wr == 1) PG8_BAR; }
    }
    PG8_WAIT_V(0);
    if constexpr (!ALIGN_EPI) { if (wr == 0) PG8_BAR; }
    PG8_BAR;
    if constexpr (Epi::AFTER_DRAIN) { E.fused(acc, cur, wr, wc, fr, fq, lds, wid, lane); S.done(cur); }
#undef PG8_SA
#undef PG8_SB
#undef PG8_STAGE
#undef PG8_LDA
#undef PG8_LDB
#undef PG8_MMA
#undef PG8_WAIT_V
#undef PG8_WAIT_L
#undef PG8_BAR
#undef PG8_SCHED
}
}
typedef unsigned short bf16;
typedef float f32x4 __attribute__((ext_vector_type(4)));
typedef unsigned u32x4 __attribute__((ext_vector_type(4)));
constexpr int NB = 2, S = 16384, D = 1024, M = NB * S, INW = 2816, FF = 4096, DEPTH = 2;
constexpr int C_A = 0, C_G = 256, C_RQ = 512, C_RK = 704, C_RV = 896, C_RG = 1280, C_AQ = 1664, C_AK = 2048, C_AV = 2432;
constexpr int MX_CONV = 0, MX_RET = 256, MX_ATT = 640;
constexpr int UAW = 1152, CA_Q = 0, CA_K = 384, CA_V = 768, UG = 26;
__device__ __forceinline__ size_t u2off(int grow, int grp) { return ((size_t)((grow >> 8) * UG + grp) * 256 + (grow & 255)) * 64; }
constexpr float EPS = 1e-6f;
constexpr size_t MiB = 1u << 20;
constexpr size_t WS_CTL = 0, CTL_BYTES = 1 * MiB;
constexpr size_t WS_W = 2 * MiB;
constexpr size_t W_LAYER = 24641536, W_IN = 0, W_OUT = 5767168, W_F1 = 7864320, W_F2 = 16252928;
constexpr size_t WS_SSQ = 50 * MiB;
constexpr size_t WS_ATAB = 56 * MiB;
constexpr size_t WS_ROPE = 52 * MiB;
constexpr size_t WS_XB = 64 * MiB;
constexpr int HP = FF + 64;
constexpr size_t WS_H = 128 * MiB;
constexpr size_t WS_U = 128 * MiB;
constexpr size_t WS_U2 = 200 * MiB;
constexpr size_t WS_MIX = 304 * MiB;
constexpr size_t WS_KV = 408 * MiB;
constexpr size_t WS_ST = 420 * MiB;
constexpr size_t WS_END = 432 * MiB;

struct P { const float* in[14]; float* out; unsigned char* ws; };

__device__ __forceinline__ float bf_lo(unsigned w) { return __uint_as_float(w << 16); }
__device__ __forceinline__ float bf_hi(unsigned w) { return __uint_as_float(w & 0xffff0000u); }
__device__ __forceinline__ unsigned f2bf(float f) { unsigned u = __float_as_uint(f); return (u + 0x7fffu + ((u >> 16) & 1u)) >> 16; }
__device__ __forceinline__ unsigned pk2(float lo, float hi) { return f2bf(lo) | (f2bf(hi) << 16); }
__device__ __forceinline__ void unpack8(const u32x4 w, float (&v)[8]) {
    v[0] = bf_lo(w.x); v[1] = bf_hi(w.x); v[2] = bf_lo(w.y); v[3] = bf_hi(w.y); v[4] = bf_lo(w.z); v[5] = bf_hi(w.z); v[6] = bf_lo(w.w); v[7] = bf_hi(w.w); }
__device__ __forceinline__ u32x4 pack8(const float (&v)[8]) { u32x4 w; w.x = pk2(v[0], v[1]); w.y = pk2(v[2], v[3]); w.z = pk2(v[4], v[5]); w.w = pk2(v[6], v[7]); return w; }
__device__ __forceinline__ float wave_sum(float v) {
#pragma unroll
    for (int o = 1; o < 64; o <<= 1) v += __shfl_xor(v, o);
    return v; }
__device__ __forceinline__ int sgpr_opaque(int v) { asm volatile("" : "+s"(v)); return v; }
__device__ __forceinline__ int tid_opaque() { int t = threadIdx.x; asm volatile("" : "+v"(t)); return t; }
__device__ __forceinline__ float gamma_log2(int h) {
    return h == 0 ? -0.04580368961312479f : h == 1 ? -0.02272007650008353f : h == 2 ? -0.011315313227834146f : h == 3 ? -0.005646563141142063f : h == 4 ? -0.0028205190623786626f : -0.0014095702546713536f; }

__device__ __forceinline__ float ssq_to_rstd(const float* ssq, int row) {
    const f32x4* q = (const f32x4*)(ssq + (size_t)row * 16); const f32x4 a = q[0], b = q[1], c = q[2], d = q[3];
    const float s = ((a.x + a.y) + (a.z + a.w)) + ((b.x + b.y) + (b.z + b.w)) + ((c.x + c.y) + (c.z + c.w)) + ((d.x + d.y) + (d.z + d.w));
    return __builtin_amdgcn_rsqf(s * (1.0f / 1024.0f) + EPS); }
template <class Sched> __device__ __forceinline__ void rstd_prepass(const Sched& So, const float* ssq, LAS float* tab) {
    const int tid = tid_opaque(), row = tid >> 1, hf = tid & 1;
    f32x4 a[8], c[8]; unsigned okm = 0u;
#pragma unroll
    for (int i = 0; i < 8; ++i) { pg8::Unit un; const bool ok = So.next(i, un); const int pm = ok ? un.pm : 0; okm |= (ok ? 1u : 0u) << i;
        const f32x4* q = (const f32x4*)(ssq + (size_t)(pm * 256 + row) * 16 + 8 * hf); a[i] = q[0]; c[i] = q[1]; }
#pragma unroll
    for (int i = 0; i < 8; ++i) {
        float s = ((a[i].x + a[i].y) + (a[i].z + a[i].w)) + ((c[i].x + c[i].y) + (c[i].z + c[i].w));
        s += __builtin_bit_cast(float, __builtin_amdgcn_mov_dpp(__builtin_bit_cast(int, s), 0xB1  , 0xf, 0xf, false));
        if (((okm >> i) & 1u) && hf == 0) tab[i * 256 + row] = __builtin_amdgcn_rsqf(s * (1.0f / 1024.0f) + EPS); }
    __syncthreads();
}
__device__ __forceinline__ void st16_wt(void* ptr, u32x4 v) { asm volatile("global_store_dwordx4 %0, %1, off sc0 sc1\n\ts_nop 1" :: "v"(ptr), "v"(v) : "memory"); }
__device__ __forceinline__ void st8_wt(void* ptr, unsigned long long v) { asm volatile("global_store_dwordx2 %0, %1, off sc0 sc1\n\ts_nop 1" :: "v"(ptr), "v"(v) : "memory"); }
__device__ __forceinline__ unsigned dpp_ror8(unsigned x) { return (unsigned)__builtin_amdgcn_mov_dpp((int)x, 0x128  , 0xf, 0xf, false); }
template <bool NT = false> __device__ __forceinline__ void store_rows_full(bf16* grp  , int ld, int fr, int fq, u32x4 d0, u32x4 d1, bool wt) {
    const bool lo = fr < 8; const u32x4 s = lo ? d1 : d0; u32x4 r; r.x = dpp_ror8(s.x); r.y = dpp_ror8(s.y); r.z = dpp_ror8(s.z); r.w = dpp_ror8(s.w);
    const u32x4 a = lo ? d0 : r, c = lo ? r : d1;
    const unsigned loff = (unsigned)(((fr & 7) * ld + (fr >> 3) * 32 + 8 * fq) * 2);
    char* pa = (char*)grp + loff; char* pc = (char*)(grp + (size_t)8 * ld) + loff;
    if (wt) {
        asm volatile("global_store_dwordx4 %0, %1, off sc0 sc1\n\ts_nop 1" :: "v"(pa), "v"(a) : "memory"); asm volatile("global_store_dwordx4 %0, %1, off sc0 sc1\n\ts_nop 1" :: "v"(pc), "v"(c) : "memory"); }
    else if (NT) { __builtin_nontemporal_store(a, (u32x4*)pa); __builtin_nontemporal_store(c, (u32x4*)pc); } else { *(u32x4*)pa = a; *(u32x4*)pc = c; } }
template <int ACT  > struct EpiNormBf16 {
    static constexpr bool PERM = true, AFTER_DRAIN = false;
    bf16* O; const LAS float* rtab; int ldc; mutable int ord;
    __device__ __forceinline__ void operator()(const pg8::f32x4 (&acc)[2][2][4][2], const pg8::Unit& u, int wr, int wc, int fr, int fq, bool wt) const {
        const int row0 = u.pm * 256 + wr * 64 + fr, col0 = u.pn * 256 + wc * 64 + 8 * fq; const LAS float* rt = rtab + ord * 256 + wr * 64 + fr; ++ord;
#pragma unroll
        for (int ai = 0; ai < 2; ++ai)
#pragma unroll
            for (int m = 0; m < 4; ++m) { const float rs = rt[ai * 128 + m * 16]; u32x4 wv[2];
#pragma unroll
                for (int bj = 0; bj < 2; ++bj) { pg8::f32x4 v0 = acc[ai][bj][m][0] * rs, v1 = acc[ai][bj][m][1] * rs;
                    if (ACT == 1) { const pg8::f32x4 z = {0.f, 0.f, 0.f, 0.f}; v0 = __builtin_elementwise_max(v0, z); v1 = __builtin_elementwise_max(v1, z); v0 = v0 * v0; v1 = v1 * v1; }
                    wv[bj].x = pg8::cvt_pk_bf16(v0[0], v0[1]); wv[bj].y = pg8::cvt_pk_bf16(v0[2], v0[3]); wv[bj].z = pg8::cvt_pk_bf16(v1[0], v1[1]); wv[bj].w = pg8::cvt_pk_bf16(v1[2], v1[3]); }
                store_rows_full<ACT == 1>(O + ((size_t)(u.pm * (FF / 64) + 4 * u.pn + wc) * 256 + ai * 128 + wr * 64 + m * 16) * 64, 64, fr, fq, wv[0], wv[1], wt); }
    }
};
struct EpiInProj {
    static constexpr bool PERM = true, AFTER_DRAIN = false;
    bf16* O; const LAS float* rtab; const float2* rope; const float* qg; const float* kg; mutable int ord; bf16* O2;
    __device__ __forceinline__ void operator()(const pg8::f32x4 (&acc)[2][2][4][2], const pg8::Unit& u, int wr, int wc, int fr, int fq, bool wt) const {
        const int colw = u.pn * 256 + wc * 64;
        const LAS float* rt = rtab + ord * 256 + wr * 64 + fr; ++ord;
        const bool att = colw >= C_AQ && colw < C_AV, isk = colw >= C_AK, rot = colw >= C_RQ && colw < C_RV;
        pg8::f32x4 gn[2][2];
#pragma unroll
        for (int bj = 0; bj < 2; ++bj) { const pg8::f32x4* gp = (const pg8::f32x4*)((isk ? kg : qg) + 32 * bj + 8 * fq); gn[bj][0] = gp[0]; gn[bj][1] = gp[1]; }
#pragma unroll
        for (int ai = 0; ai < 2; ++ai) {
            pg8::f32x4 rc[4][2];
            if (rot) {
#pragma unroll
                for (int m = 0; m < 4; ++m) { const int pos = (u.pm * 256 + ai * 128 + wr * 64 + m * 16 + fr) & (S - 1); const pg8::f32x4* rp4 = (const pg8::f32x4*)(rope + pos * 16 + 4 * fq); rc[m][0] = rp4[0]; rc[m][1] = rp4[1]; } }
#pragma unroll
            for (int m = 0; m < 4; ++m) { const int rl = ai * 128 + wr * 64 + m * 16 + fr, row = u.pm * 256 + rl; const float rs = rt[ai * 128 + m * 16];
                pg8::f32x4 v[2][2];
#pragma unroll
                for (int bj = 0; bj < 2; ++bj) { v[bj][0] = acc[ai][bj][m][0] * rs; v[bj][1] = acc[ai][bj][m][1] * rs; }
                if (att) {
                    float q = 0.f;
#pragma unroll
                    for (int bj = 0; bj < 2; ++bj)
#pragma unroll
                        for (int n = 0; n < 2; ++n) q += (v[bj][n][0] * v[bj][n][0] + v[bj][n][1] * v[bj][n][1]) + (v[bj][n][2] * v[bj][n][2] + v[bj][n][3] * v[bj][n][3]);
                    q += __shfl_xor(q, 16); q += __shfl_xor(q, 32);
                    const float r = __builtin_amdgcn_rsqf(q * (1.0f / 64.0f) + EPS) * (isk ? 1.0f : 0.125f);
#pragma unroll
                    for (int bj = 0; bj < 2; ++bj) { v[bj][0] = v[bj][0] * r * gn[bj][0]; v[bj][1] = v[bj][1] * r * gn[bj][1]; }
                } else {
#pragma unroll
                    for (int bj = 0; bj < 2; ++bj) { const int cg = colw + 32 * bj;
                        if (cg >= C_RQ && cg < C_RV) {
                            const bool rk = cg >= C_RK; const int h = ((rk ? cg - C_RK : cg - C_RQ) >> 5);
                            const int pos = row & (S - 1); const float dq = (float)(pos & 127) * gamma_log2(h); const float sc = rk ? 0.17677669529663687f * __builtin_amdgcn_exp2f(-dq) : __builtin_amdgcn_exp2f(dq);
                            const pg8::f32x4 c01 = rc[m][0], c23 = rc[m][1];
                            const pg8::f32x4 a0 = v[bj][0], a1 = v[bj][1];
                            v[bj][0][0] = (a0[0] * c01[0] - a0[1] * c01[1]) * sc; v[bj][0][1] = (a0[0] * c01[1] + a0[1] * c01[0]) * sc; v[bj][0][2] = (a0[2] * c01[2] - a0[3] * c01[3]) * sc; v[bj][0][3] = (a0[2] * c01[3] + a0[3] * c01[2]) * sc;
                            v[bj][1][0] = (a1[0] * c23[0] - a1[1] * c23[1]) * sc; v[bj][1][1] = (a1[0] * c23[1] + a1[1] * c23[0]) * sc; v[bj][1][2] = (a1[2] * c23[2] - a1[3] * c23[3]) * sc; v[bj][1][3] = (a1[2] * c23[3] + a1[3] * c23[2]) * sc; } } }
                u32x4 wv[2];
#pragma unroll
                for (int bj = 0; bj < 2; ++bj) { wv[bj].x = pg8::cvt_pk_bf16(v[bj][0][0], v[bj][0][1]); wv[bj].y = pg8::cvt_pk_bf16(v[bj][0][2], v[bj][0][3]); wv[bj].z = pg8::cvt_pk_bf16(v[bj][1][0], v[bj][1][1]); wv[bj].w = pg8::cvt_pk_bf16(v[bj][1][2], v[bj][1][3]); }
                if (colw < C_AQ) store_rows_full(O2 + ((size_t)(u.pm * UG + (colw >> 6)) * 256 + ai * 128 + wr * 64 + m * 16) * 64, 64, fr, fq, wv[0], wv[1], wt);
                else store_rows_full(O + (size_t)(u.pm * 256 + ai * 128 + wr * 64 + m * 16) * UAW + (colw - C_AQ), UAW, fr, fq, wv[0], wv[1], wt); }
        }
    }
};
struct EpiRes {
    static constexpr bool PERM = true, AFTER_DRAIN = false;
    const float* xf; bf16* xb; float* ssq; float* outf;
    __device__ __forceinline__ void operator()(const pg8::f32x4 (&acc)[2][2][4][2], const pg8::Unit& u, int wr, int wc, int fr, int fq, bool wt) const {
        const int row0 = u.pm * 256 + wr * 64 + fr, col0 = u.pn * 256 + wc * 64 + 8 * fq;
#pragma unroll
        for (int ai2 = 0; ai2 < 4; ++ai2) { const int ai = ai2 >> 1, mb = 2 * (ai2 & 1);
            pg8::f32x4 ra[2][2][2];
            if (xf) {
#pragma unroll
                for (int m = 0; m < 2; ++m)
#pragma unroll
                    for (int bj = 0; bj < 2; ++bj) { const size_t off = (size_t)(row0 + ai * 128 + (mb + m) * 16) * D + col0 + bj * 32;
                        ra[m][bj][0] = __builtin_nontemporal_load((const pg8::f32x4*)(xf + off)); ra[m][bj][1] = __builtin_nontemporal_load((const pg8::f32x4*)(xf + off + 4)); }
            } else {
                u32x4 w[2][2];
#pragma unroll
                for (int m = 0; m < 2; ++m)
#pragma unroll
                    for (int bj = 0; bj < 2; ++bj) { const u32x4* rp = (const u32x4*)(xb + (size_t)(row0 + ai * 128 + (mb + m) * 16) * D + col0 + bj * 32); w[m][bj] = outf ? __builtin_nontemporal_load(rp) : *rp; }
#pragma unroll
                for (int m = 0; m < 2; ++m)
#pragma unroll
                    for (int bj = 0; bj < 2; ++bj) { const u32x4 t = w[m][bj]; ra[m][bj][0] = (pg8::f32x4){bf_lo(t.x), bf_hi(t.x), bf_lo(t.y), bf_hi(t.y)}; ra[m][bj][1] = (pg8::f32x4){bf_lo(t.z), bf_hi(t.z), bf_lo(t.w), bf_hi(t.w)}; }
            }
#pragma unroll
            for (int m2 = 0; m2 < 2; ++m2) { const int m = mb + m2, row = row0 + ai * 128 + m * 16; float q = 0.f; u32x4 wv[2] = {{0u, 0u, 0u, 0u}, {0u, 0u, 0u, 0u}};
#pragma unroll
                for (int bj = 0; bj < 2; ++bj) { const size_t off = (size_t)row * D + col0 + bj * 32;
                    const pg8::f32x4 v0 = acc[ai][bj][m][0] + ra[m2][bj][0], v1 = acc[ai][bj][m][1] + ra[m2][bj][1];
                    if (outf) { __builtin_nontemporal_store(v0, (pg8::f32x4*)(outf + off)); __builtin_nontemporal_store(v1, (pg8::f32x4*)(outf + off + 4)); }
                    else { q += (v0[0] * v0[0] + v0[1] * v0[1]) + (v0[2] * v0[2] + v0[3] * v0[3]) + (v1[0] * v1[0] + v1[1] * v1[1]) + (v1[2] * v1[2] + v1[3] * v1[3]);
                        wv[bj].x = pg8::cvt_pk_bf16(v0[0], v0[1]); wv[bj].y = pg8::cvt_pk_bf16(v0[2], v0[3]); wv[bj].z = pg8::cvt_pk_bf16(v1[0], v1[1]); wv[bj].w = pg8::cvt_pk_bf16(v1[2], v1[3]); } }
                if (!outf) store_rows_full<true>(xb + (size_t)(u.pm * 256 + ai * 128 + wr * 64 + m * 16) * D + u.pn * 256 + wc * 64, D, fr, fq, wv[0], wv[1], wt);
                if (!outf) { q += __shfl_xor(q, 16); q += __shfl_xor(q, 32);
                    if (fq == 0) ssq[(size_t)row * 16 + u.pn * 4 + wc] = q; } }
        }
    }
};

__device__ __forceinline__ void transpose_item(const float* W, const float* g, int K, int N, bf16* WT, LAS float* scr, int item, int lane) {
    const int nblk = N / 32, kb = item / nblk, nb = item % nblk, k0 = 64 * kb, n0 = 32 * nb;
    f32x4 v[8];
#pragma unroll
    for (int i = 0; i < 8; ++i) v[i] = __builtin_nontemporal_load((const f32x4*)(W + (size_t)(k0 + 8 * i + (lane >> 3)) * N + n0 + 4 * (lane & 7)));
#pragma unroll
    for (int i = 0; i < 8; ++i) { const int kk = 8 * i + (lane >> 3); const float sc = g ? g[k0 + kk] : 1.0f; LAS float* d = scr + kk * 33 + 4 * (lane & 7);
        d[0] = v[i].x * sc; d[1] = v[i].y * sc; d[2] = v[i].z * sc; d[3] = v[i].w * sc; }
    asm volatile("s_waitcnt lgkmcnt(0)" ::: "memory");
    const int c = lane & 7;
#pragma unroll
    for (int j = 0; j < 4; ++j) { const int n = (lane >> 3) + 8 * j; const LAS float* s = scr + (8 * c) * 33 + n;
        u32x4 o; o.x = pk2(s[0 * 33], s[1 * 33]); o.y = pk2(s[2 * 33], s[3 * 33]); o.z = pk2(s[4 * 33], s[5 * 33]); o.w = pk2(s[6 * 33], s[7 * 33]);
        st16_wt(WT + ((size_t)((n0 + n) >> 8) * (K / 64) + (k0 >> 6)) * 16384 + ((n0 + n) & 255) * 64 + 8 * c, o); }
    asm volatile("s_waitcnt lgkmcnt(0)" ::: "memory");
}
__device__ __forceinline__ void ph_wconv(const P& p, unsigned char* lds, int bid, int G) {
    const int tid = tid_opaque(), lane = tid & 63, wave = tid >> 6;
    LAS float* scr = (LAS float*)((LAS unsigned char*)lds + wave * 16384);
    const int gw = bid * 8 + wave, NGW = G * 8;
    for (int it = gw; it < 2 * 6016; it += NGW) {
        const int l = it / 6016; int r = it % 6016; unsigned char* wb = p.ws + WS_W + (size_t)l * W_LAYER;
        if (r < 1408) { transpose_item(p.in[2] + (size_t)l * D * INW, p.in[1] + l * D, D, INW, (bf16*)(wb + W_IN), scr, r, lane); continue; } r -= 1408;
        if (r < 512) { transpose_item(p.in[9] + (size_t)l * D * D, nullptr, D, D, (bf16*)(wb + W_OUT), scr, r, lane); continue; } r -= 512;
        if (r < 2048) { transpose_item(p.in[11] + (size_t)l * D * FF, p.in[10] + l * D, D, FF, (bf16*)(wb + W_F1), scr, r, lane); continue; } r -= 2048;
        transpose_item(p.in[12] + (size_t)l * FF * D, nullptr, FF, D, (bf16*)(wb + W_F2), scr, r, lane);
    }
}
__device__ __forceinline__ void ph_xprep(const P& p, int bid, int G) {
    const int tid = tid_opaque(), lane = tid & 63, wave = tid >> 6; const int gw = bid * 8 + wave, NGW = G * 8;
    const float* x = p.in[0]; bf16* xb = (bf16*)(p.ws + WS_XB); float* ssq = (float*)(p.ws + WS_SSQ);
    for (int m0 = 2 * gw; m0 < M; m0 += 2 * NGW) {
        f32x4 v[2][4];
#pragma unroll
        for (int r = 0; r < 2; ++r) { const f32x4* xr = (const f32x4*)(x + (size_t)(m0 + r) * D) + lane;
#pragma unroll
            for (int j = 0; j < 4; ++j) v[r][j] = __builtin_nontemporal_load(xr + 64 * j); }
#pragma unroll
        for (int r = 0; r < 2; ++r) { const int m = m0 + r; float s = 0.f;
#pragma unroll
            for (int j = 0; j < 4; ++j) s += (v[r][j].x * v[r][j].x + v[r][j].y * v[r][j].y) + (v[r][j].z * v[r][j].z + v[r][j].w * v[r][j].w);
            s = wave_sum(s);
            unsigned long long* o8 = (unsigned long long*)(xb + (size_t)m * D) + lane;
#pragma unroll
            for (int j = 0; j < 4; ++j) st8_wt(o8 + 64 * j, (unsigned long long)pk2(v[r][j].x, v[r][j].y) | ((unsigned long long)pk2(v[r][j].z, v[r][j].w) << 32));
            if (lane < 16) ssq[(size_t)m * 16 + lane] = lane == 0 ? s : 0.f; }
    }
    float2* rope = (float2*)(p.ws + WS_ROPE);
    for (int i = bid * 512 + tid; i < S * 16; i += G * 512) { const int pos = i >> 4, k = i & 15;
        const float e = (float)k / 15.0f; const float inv = 1.0f / powf(10000.0f, e); const float ang = (float)pos * inv;
        rope[i] = make_float2((float)cos((double)ang), (float)sin((double)ang)); }
}
__device__ __forceinline__ float wave_sum_dpp(float v) {
    v += __builtin_bit_cast(float, __builtin_amdgcn_update_dpp(0, __builtin_bit_cast(int, v), 0xB1, 0xf, 0xf, false));
    v += __builtin_bit_cast(float, __builtin_amdgcn_update_dpp(0, __builtin_bit_cast(int, v), 0x4E, 0xf, 0xf, false));
    v += __builtin_bit_cast(float, __builtin_amdgcn_update_dpp(0, __builtin_bit_cast(int, v), 0x141, 0xf, 0xf, false));
    v += __builtin_bit_cast(float, __builtin_amdgcn_update_dpp(0, __builtin_bit_cast(int, v), 0x140, 0xf, 0xf, false));
    const int iv = __builtin_bit_cast(int, v);
    return (__builtin_bit_cast(float, __builtin_amdgcn_readlane(iv, 0)) + __builtin_bit_cast(float, __builtin_amdgcn_readlane(iv, 16))) + (__builtin_bit_cast(float, __builtin_amdgcn_readlane(iv, 32)) + __builtin_bit_cast(float, __builtin_amdgcn_readlane(iv, 48)));
}
__device__ __forceinline__ void ph_conv(const P& p, int layer, unsigned char* lds, int bid, int G, int early  ) {
    const int tid = tid_opaque(); const bf16* u = (const bf16*)(p.ws + WS_U); bf16* mix = (bf16*)(p.ws + WS_MIX);
    float* hl = (float*)lds;
    const int c = tid & 255, half = tid >> 8;
    float W[31];
#pragma unroll
    for (int w = 0; w < 31; ++w) W[w] = p.in[3][(size_t)layer * 31 * 256 + w * 256 + c];
    const float bias = p.in[4][layer * 256 + c], gain = p.in[5][layer * 256 + c];
    int cu0 = bid, cn = early ? 0 : (M / 64 - bid + G - 1) / G, cst = G;
    if (G == 256) { cst = 1;
        if (early) { cu0 = 256 + 2 * (bid - 128); cn = bid >= 128 ? 2 : 0; }
        else { if (bid >= 192) { cu0 = 3 * (bid - 192); cn = 3; } else if (bid >= 128) { cu0 = 192 + (bid - 128); cn = 1; } else cn = 0; } }
    for (int ck = 0; ck < cn; ++ck) { const int unit = cu0 + ck * cst;
        const int b = unit / (S / 64), t0 = (unit % (S / 64)) * 64;
        const bf16* u2 = (const bf16*)(p.ws + WS_U2);
        u32x4 ra[6], rg[6];
#pragma unroll
        for (int k = 0; k < 6; ++k) { const int task = min(tid + 512 * k, 94 * 32 - 1), r = task >> 5, c8 = (task & 31) * 8; const int tok = max(t0 - 30 + r, 0);
            const bf16* up = u2 + u2off(b * S + tok, c8 >> 6) + (c8 & 63); ra[k] = *(const u32x4*)up; rg[k] = *(const u32x4*)(up + 4 * 16384); }
#pragma unroll
        for (int k = 0; k < 6; ++k) { const int task = min(tid + 512 * k, 94 * 32 - 1), r = task >> 5, c8 = (task & 31) * 8; const float keep = (t0 - 30 + r) >= 0 ? 1.0f : 0.0f;
            float a[8], g[8], h[8]; unpack8(ra[k], a); unpack8(rg[k], g);
#pragma unroll
            for (int t = 0; t < 8; ++t) h[t] = keep * a[t] * __builtin_amdgcn_rcpf(1.0f + __expf(-g[t]));
            *(f32x4*)(hl + r * 256 + c8) = (f32x4){h[0], h[1], h[2], h[3]}; *(f32x4*)(hl + r * 256 + c8 + 4) = (f32x4){h[4], h[5], h[6], h[7]}; }
        __syncthreads();
#pragma unroll 1
        for (int run = 0; run < 2; ++run) {
            const int tb = half * 32 + run * 16;
            float win[46];
#pragma unroll
            for (int i = 0; i < 46; ++i) win[i] = hl[(tb + i) * 256 + c];
#pragma unroll
            for (int tt = 0; tt < 16; ++tt) { float acc = bias;
#pragma unroll
                for (int w = 0; w < 31; ++w) acc = fmaf(W[w], win[tt + w], acc);
                const float ss = wave_sum_dpp(acc * acc); float y = acc * __builtin_amdgcn_rsqf(ss * (1.0f / 64.0f) + EPS) * gain; y = y * __builtin_amdgcn_rcpf(1.0f + __expf(-y));
                mix[(size_t)(b * S + t0 + tb + tt) * D + MX_CONV + c] = (bf16)f2bf(y); }
        }
        __syncthreads();
    }
}
typedef short bf16x8_t __attribute__((ext_vector_type(8)));
typedef float f32x16 __attribute__((ext_vector_type(16)));
typedef short s16x4_t __attribute__((ext_vector_type(4)));
constexpr int A2_TAB = 1376, A2_T1 = 0, A2_T4 = 192, A2_T1A = 576;
constexpr int A2_LDS_V = 33792, A2_LDS_K = A2_LDS_V + 8 * 4096, A2_LDS_OX = A2_LDS_K + 8 * 4096, A2_LDS_LX = A2_LDS_OX + 256 * 64 * 2;
constexpr float LOG2E = 1.4426950408889634f;
__device__ __forceinline__ unsigned cvtpk(float lo, float hi) { typedef float f2 __attribute__((ext_vector_type(2))); typedef __bf16 b2 __attribute__((ext_vector_type(2))); f2 v = {lo, hi}; b2 b = __builtin_convertvector(v, b2); return __builtin_bit_cast(unsigned, b); }
__device__ __forceinline__ void at2_compute(const LAS unsigned char* krd, int ksel, const bf16x8_t (&qf)[4], const float* tp_, int kneg, int hh, unsigned char* vs, int vroff, int tsw, f32x16& o0, f32x16& o1, f32x16& lacc) {
    f32x16 s;
#pragma unroll
    for (int i = 0; i < 16; ++i) s[i] = 0.f;
#pragma unroll
    for (int t = 0; t < 4; ++t) s = __builtin_amdgcn_mfma_f32_32x32x16_bf16(*(const LAS bf16x8_t*)(krd + (((2 * t) ^ ksel) * 16)), qf[t], s, 0, 0, 0);
    float pe[16];
#pragma unroll
    for (int i = 0; i < 16; ++i) pe[i] = __builtin_amdgcn_exp2f(fmaf(s[i], LOG2E, tp_[(i & 3) + 8 * (i >> 2)]));
    if (kneg > 0) {
        asm volatile("" ::: "memory");
#pragma unroll
        for (int i = 0; i < 16; ++i) if ((i & 3) + 8 * (i >> 2) + 4 * hh < kneg) pe[i] = 0.f; }
    bf16x8_t pf[2];
#pragma unroll
    for (int sx = 0; sx < 2; ++sx) { u32x4 w; w.x = cvtpk(pe[8 * sx + 0], pe[8 * sx + 1]); w.y = cvtpk(pe[8 * sx + 2], pe[8 * sx + 3]); w.z = cvtpk(pe[8 * sx + 4], pe[8 * sx + 5]); w.w = cvtpk(pe[8 * sx + 6], pe[8 * sx + 7]); pf[sx] = __builtin_bit_cast(bf16x8_t, w); }
    const bf16x8_t ones = (bf16x8_t){0x3F80, 0x3F80, 0x3F80, 0x3F80, 0x3F80, 0x3F80, 0x3F80, 0x3F80};
#pragma unroll
    for (int sx = 0; sx < 2; ++sx) {
        lacc = __builtin_amdgcn_mfma_f32_32x32x16_bf16(pf[sx], ones, lacc, 0, 0, 0);
#pragma unroll
        for (int db = 0; db < 2; ++db) {
            const LAS unsigned char* va = (const LAS unsigned char*)vs + vroff + sx * 2048 + ((db ^ tsw) * 64);
            const s16x4_t lo = __builtin_bit_cast(s16x4_t, __builtin_amdgcn_ds_read_tr16_b64_v4i16((LAS s16x4_t*)va));
            const s16x4_t hi = __builtin_bit_cast(s16x4_t, __builtin_amdgcn_ds_read_tr16_b64_v4i16((LAS s16x4_t*)(va + 1024)));
            const bf16x8_t vf = (bf16x8_t){lo[0], lo[1], lo[2], lo[3], hi[0], hi[1], hi[2], hi[3]};
            if (db == 0) o0 = __builtin_amdgcn_mfma_f32_32x32x16_bf16(pf[sx], vf, o0, 0, 0, 0); else o1 = __builtin_amdgcn_mfma_f32_32x32x16_bf16(pf[sx], vf, o1, 0, 0, 0); } }
}
__device__ __forceinline__ void ph_attn_tables(const P& p, int bid, int G) {
    const int tid = tid_opaque(); const float* rb = p.in[13]; float* out = (float*)(p.ws + WS_ATAB);
    const int total = DEPTH * 6 * A2_TAB;
    for (int e0 = bid * 512; e0 < total; e0 += G * 512) {
        const int ln = tid & 63;
        float q0 = fabsf(p.in[7][ln]), q1 = fabsf(p.in[7][64 + ln]), k0 = fabsf(p.in[8][ln]), k1 = fabsf(p.in[8][64 + ln]);
        float mb = fmaxf(fmaxf(rb[ln], rb[64 + ln]), fmaxf(rb[128 + ln], 0.f));
#pragma unroll
        for (int sft = 1; sft < 64; sft <<= 1) {
            q0 = fmaxf(q0, __shfl_xor(q0, sft)); q1 = fmaxf(q1, __shfl_xor(q1, sft));
            k0 = fmaxf(k0, __shfl_xor(k0, sft)); k1 = fmaxf(k1, __shfl_xor(k1, sft));
            mb = fmaxf(mb, __shfl_xor(mb, sft)); }
        const int e = e0 + tid; if (e >= total) continue;
        const int l = e / (6 * A2_TAB), r = e % (6 * A2_TAB), hd = r / A2_TAB, x = r % A2_TAB;
        const float cshift = 8.0f * (l ? q1 : q0) * (l ? k1 : k0) + mb;
        int dl, dist;
        if (x < A2_T4) { dl = 16; dist = 128 - (x - 31); } else if (x < A2_T1A) { dl = 4; dist = 128 - (x - A2_T4 - 124); } else { const int z = x - A2_T1A; dl = 1; dist = 128 + 16 * (z / 200) - (z % 200 - 7); }
        float v = -1e30f;
        if (dist >= 0 && dist <= 128) { const int n = dist * dl; int bucket;
            if (n < 16) bucket = n; else { const float nf = (float)n; const int lg = 16 + (int)(logf(nf / 16.0f) / 4.852030263919617f * 16.0f); bucket = lg < 31 ? lg : 31; }
            v = (rb[bucket * 6 + hd] - cshift) * LOG2E; }
        out[e] = v; }
}
__device__ __forceinline__ void ph_attn(const P& p, int layer, unsigned char* lds, int bid, int G) {
    const int tid = tid_opaque(), lane = tid & 63, wave = __builtin_amdgcn_readfirstlane(tid >> 6);
    float* tab = (float*)lds;
    {   const f32x4* src = (const f32x4*)(p.ws + WS_ATAB) + (size_t)layer * (6 * A2_TAB / 4);
        constexpr int NV = 6 * A2_TAB / 4, NI = (NV + 511) / 512; f32x4 tv[NI];
#pragma unroll
        for (int i = 0; i < NI; ++i) tv[i] = src[min(tid + 512 * i, NV - 1)];
#pragma unroll
        for (int i = 0; i < NI; ++i) if (tid + 512 * i < NV) ((f32x4*)tab)[tid + 512 * i] = tv[i]; }
    __syncthreads();
    const bf16* u = (const bf16*)(p.ws + WS_U); bf16* mix = (bf16*)(p.ws + WS_MIX);
    unsigned char* vs = lds + A2_LDS_V + wave * 4096; unsigned char* ksw = lds + A2_LDS_K + wave * 4096; bf16* Ox = (bf16*)(lds + A2_LDS_OX); float* lx = (float*)(lds + A2_LDS_LX);
    const int r32 = lane & 31, hh = lane >> 5;
    const int vrow = lane >> 3, vch = lane & 7;
    const int vwoff = vrow * 128 + ((vch ^ (((vrow >> 1) & 1) << 2)) * 16);
    const int tq = (lane & 15) >> 2, tp = lane & 3, tsw = (tq >> 1) & 1;
    const int vroff = (4 * hh + tq) * 128 + (2 * ((lane >> 4) & 1) + (tp >> 1)) * 16 + (tp & 1) * 8;
    const int kwoff = vrow * 128 + ((vch ^ vrow) * 16);
    const int ksel = hh ^ (r32 & 7);
    const LAS unsigned char* krd = (const LAS unsigned char*)ksw + r32 * 128;
#define A2_UNIT(BU, HALF, SP, HD, B) do { if (G == 256) { const int xcd_ = bid & 7, slot_ = bid >> 3, k_ = (BU) >> 8, bh_ = 4 * k_ + (xcd_ >> 1); HALF = slot_ & 1; SP = 16 * (xcd_ & 1) + (slot_ >> 1); HD = bh_ % 6; B = bh_ / 6; } \
        else { HALF = (BU) & 1; SP = ((BU) >> 1) & 31; HD = ((BU) >> 6) % 6; B = (BU) / 384; } } while (0)
    const int rot = (4 * wave) % 6;
#define A2_KT(T) (((T) + rot) % 6)
#define A2_PREF_A(UBN, BASEN) do { const int pkb_ = (BASEN) - 128 + 32 * A2_KT(0); \
        _Pragma("unroll") for (int it_ = 0; it_ < 4; ++it_) kA[it_] = *(const u32x4*)((const char*)(UBN) + (unsigned)(min(max(pkb_ + vrow + 8 * it_, 0), S - 1) * (UAW * 2) + (CA_K + 8 * vch) * 2)); \
        _Pragma("unroll") for (int it_ = 0; it_ < 4; ++it_) vA[it_] = *(const u32x4*)((const char*)(UBN) + (unsigned)(min(max(pkb_ + vrow + 8 * it_, 0), S - 1) * (UAW * 2) + (CA_V + 8 * vch) * 2)); \
        { const bf16* qp_ = (UBN) + (size_t)((BASEN) + 16 * (r32 >> 3) + (r32 & 7)) * UAW + CA_Q + 8 * hh; \
          _Pragma("unroll") for (int t_ = 0; t_ < 4; ++t_) qfa[t_] = *(const bf16x8_t*)(qp_ + 16 * t_); } } while (0)
    u32x4 kA[4], kB[4], vA[4], vB[4];
    bf16x8_t qfa[4], qfb[4];
    int half = 0, sp = 0, hd = 0, b = 0;
    if (bid < 768) { A2_UNIT(bid, half, sp, hd, b); A2_PREF_A(u + (size_t)b * S * UAW + hd * 64, sp * 512 + 64 * wave + 8 * half); }
    for (int bu = bid; bu < 768; bu += G) {
        const int p0 = sp * 512, rr0 = 8 * half;
        const bf16* ub = u + (size_t)b * S * UAW + hd * 64;
        const float* tbh = tab + hd * A2_TAB;
        f32x16 o0, o1, lacc;
#pragma unroll
        for (int i = 0; i < 16; ++i) { o0[i] = 0.f; o1[i] = 0.f; lacc[i] = 0.f; }
        const int rr = rr0 + wave;
        const int k1 = max(0, 4 - p0 / 512), k4b = max(0, 4 - p0 / 128), k4 = k4b - ((k4b > 0 && rr >= 4) ? 1 : 0);
        const int n1 = 5 - k1, NT = n1 + 8 - k4;
        int d_pkb, d_tb, d_kneg, d_dls;
        { const int t = min(lane, NT - 1);
          if (t < n1) { const int kt = k1 + t; d_dls = 4; d_pkb = p0 + rr - 2048 + 512 * kt; d_tb = A2_T1 + 31 + 32 * kt; }
          else { const int kt = k4 + t - n1; d_dls = 2; d_pkb = p0 + rr - 512 + 128 * kt; d_tb = A2_T4 + 124 + 32 * kt; }
          d_kneg = lane >= NT ? 32 : (d_pkb < 0 ? ((-d_pkb + (1 << d_dls) - 1) >> d_dls) : 0); }
#define A2_ISSUE_B(F, KR, VR) do { const int pkb_ = __builtin_amdgcn_readlane(d_pkb, (F)), dls_ = __builtin_amdgcn_readlane(d_dls, (F)); \
                _Pragma("unroll") for (int it_ = 0; it_ < 4; ++it_) KR[it_] = *(const u32x4*)((const char*)ub + (unsigned)(min(max(pkb_ + ((vrow + 8 * it_) << dls_), 0), S - 1) * (UAW * 2) + (CA_K + 8 * vch) * 2)); \
                _Pragma("unroll") for (int it_ = 0; it_ < 4; ++it_) VR[it_] = *(const u32x4*)((const char*)ub + (unsigned)(min(max(pkb_ + ((vrow + 8 * it_) << dls_), 0), S - 1) * (UAW * 2) + (CA_V + 8 * vch) * 2)); } while (0)
        {   const int base = p0 + 64 * wave + rr0;
            const float* tpa = tbh + A2_T1A + (r32 >> 3) * 200 + 7 - (r32 & 7) + 4 * hh;
#define A2_ISSUE_A(T, KR, VR) do { const int pkb_ = base - 128 + 32 * A2_KT(T); \
                _Pragma("unroll") for (int it_ = 0; it_ < 4; ++it_) KR[it_] = *(const u32x4*)((const char*)ub + (unsigned)(min(max(pkb_ + vrow + 8 * it_, 0), S - 1) * (UAW * 2) + (CA_K + 8 * vch) * 2)); \
                _Pragma("unroll") for (int it_ = 0; it_ < 4; ++it_) VR[it_] = *(const u32x4*)((const char*)ub + (unsigned)(min(max(pkb_ + vrow + 8 * it_, 0), S - 1) * (UAW * 2) + (CA_V + 8 * vch) * 2)); } while (0)
#define A2_STEP_A(T, KR, VR, KN, VN) do { \
                _Pragma("unroll") for (int it_ = 0; it_ < 4; ++it_) { *(u32x4*)(vs + vwoff + it_ * 1024) = VR[it_]; *(u32x4*)(ksw + kwoff + it_ * 1024) = KR[it_]; } \
                A2_ISSUE_A((T) + 1, KN, VN); \
                { const int kt_ = A2_KT(T), pkb_ = base - 128 + 32 * kt_; const int kneg_ = min(max(0, -pkb_), 32); \
                  at2_compute(krd, ksel, qfa, tpa + 32 * kt_, kneg_, hh, vs, vroff, tsw, o0, o1, lacc); } } while (0)
#pragma unroll 1
            for (int t = 0; t < 4; t += 2) { A2_STEP_A(t, kA, vA, kB, vB); A2_STEP_A(t + 1, kB, vB, kA, vA); }
            A2_STEP_A(4, kA, vA, kB, vB);
            { _Pragma("unroll") for (int it_ = 0; it_ < 4; ++it_) { *(u32x4*)(vs + vwoff + it_ * 1024) = vB[it_]; *(u32x4*)(ksw + kwoff + it_ * 1024) = kB[it_]; }
              A2_ISSUE_B(0, kA, vA);
              { const bf16* qp = ub + (size_t)(p0 + rr + 16 * r32) * UAW + CA_Q + 8 * hh;
                _Pragma("unroll") for (int t = 0; t < 4; ++t) qfb[t] = *(const bf16x8_t*)(qp + 16 * t); }
              const int kt_ = A2_KT(5), pkb_ = base - 128 + 32 * kt_; at2_compute(krd, ksel, qfa, tpa + 32 * kt_, min(max(0, -pkb_), 32), hh, vs, vroff, tsw, o0, o1, lacc); }
#undef A2_ISSUE_A
#undef A2_STEP_A
            bf16* oxw = Ox + (32 * wave + 4 * hh) * 64 + r32; float* lxw = lx + 32 * wave + 4 * hh;
#pragma unroll
            for (int i = 0; i < 16; ++i) { const int ci = (i & 3) + 8 * (i >> 2); oxw[ci * 64] = (bf16)f2bf(o0[i]); oxw[ci * 64 + 32] = (bf16)f2bf(o1[i]); if (r32 == 0) lxw[ci] = lacc[i]; }
        }
        __syncthreads();
        int half_n, sp_n, hd_n, b_n;
        {   const bf16* oxr = Ox + (32 * hh + wave) * 64 + r32; const float* lxr = lx + 32 * hh + wave;
#pragma unroll
            for (int i = 0; i < 16; ++i) { const int ci = 8 * ((i & 3) + 8 * (i >> 2)); o0[i] = bf_lo((unsigned)oxr[ci * 64]); o1[i] = bf_lo((unsigned)oxr[ci * 64 + 32]); lacc[i] = lxr[ci]; }
#define A2_STEP_B(F, KR, VR, KN, VN) do { \
                _Pragma("unroll") for (int it_ = 0; it_ < 4; ++it_) { *(u32x4*)(vs + vwoff + it_ * 1024) = VR[it_]; *(u32x4*)(ksw + kwoff + it_ * 1024) = KR[it_]; } \
                A2_ISSUE_B((F) + 1, KN, VN); \
                { const int tb_ = __builtin_amdgcn_readlane(d_tb, (F)), kneg_ = __builtin_amdgcn_readlane(d_kneg, (F)), dls_ = __builtin_amdgcn_readlane(d_dls, (F)); \
                  at2_compute(krd, ksel, qfb, tbh + tb_ - (r32 << (4 - dls_)) + 4 * hh, kneg_, hh, vs, vroff, tsw, o0, o1, lacc); } } while (0)
            int f = 0;
            for (; f + 1 < NT; f += 2) { A2_STEP_B(f, kA, vA, kB, vB); A2_STEP_B(f + 1, kB, vB, kA, vA); }
            const bool odd = f < NT;
            if (odd) { _Pragma("unroll") for (int it_ = 0; it_ < 4; ++it_) { *(u32x4*)(vs + vwoff + it_ * 1024) = vA[it_]; *(u32x4*)(ksw + kwoff + it_ * 1024) = kA[it_]; } }
            { const int bn = bu + G < 768 ? bu + G : bu; A2_UNIT(bn, half_n, sp_n, hd_n, b_n);
              A2_PREF_A(u + (size_t)b_n * S * UAW + hd_n * 64, sp_n * 512 + 64 * wave + 8 * half_n); }
            if (odd) {
                const int tb_ = __builtin_amdgcn_readlane(d_tb, f), kneg_ = __builtin_amdgcn_readlane(d_kneg, f), dls_ = __builtin_amdgcn_readlane(d_dls, f);
                at2_compute(krd, ksel, qfb, tbh + tb_ - (r32 << (4 - dls_)) + 4 * hh, kneg_, hh, vs, vroff, tsw, o0, o1, lacc); }
#undef A2_STEP_B
            bf16* ot = (bf16*)ksw;
#pragma unroll
            for (int i = 0; i < 16; ++i) { const int qi = (i & 3) + 8 * (i >> 2) + 4 * hh; const float il = __builtin_amdgcn_rcpf(lacc[i]);
                ot[qi * 64 + r32] = (bf16)f2bf(o0[i] * il); ot[qi * 64 + 32 + r32] = (bf16)f2bf(o1[i] * il); }
            { const int orow = lane >> 1, oh = lane & 1; const u32x4* os = (const u32x4*)(ot + orow * 64 + 32 * oh);
              u32x4* og = (u32x4*)(mix + ((size_t)b * S + p0 + rr + 16 * orow) * D + MX_ATT + hd * 64 + 32 * oh);
#pragma unroll
              for (int k = 0; k < 4; ++k) og[k] = os[k]; }
        }
#undef A2_ISSUE_B
        __syncthreads();
        half = half_n; sp = sp_n; hd = hd_n; b = b_n;
    }
#undef A2_PREF_A
#undef A2_KT
#undef A2_UNIT
    __syncthreads();
}
__device__ __forceinline__ bf16x8_t tr2(const LAS unsigned char* a, int second) {
    const s16x4_t lo = __builtin_bit_cast(s16x4_t, __builtin_amdgcn_ds_read_tr16_b64_v4i16((LAS s16x4_t*)a));
    const s16x4_t hi = __builtin_bit_cast(s16x4_t, __builtin_amdgcn_ds_read_tr16_b64_v4i16((LAS s16x4_t*)(a + second)));
    return (bf16x8_t){lo[0], lo[1], lo[2], lo[3], hi[0], hi[1], hi[2], hi[3]}; }
__device__ __forceinline__ void ph_retI(const P& p, unsigned char* lds, int bid_, int G) {
    const int bid = sgpr_opaque(bid_);
    const int tid = tid_opaque(), lane = tid & 63, wave = __builtin_amdgcn_readfirstlane(tid >> 6), r32 = lane & 31, hh = lane >> 5;
    const bf16* u = (const bf16*)(p.ws + WS_U); float* Pb = (float*)(p.ws + WS_KV); float* Xb = (float*)(p.ws + WS_ST);
    unsigned char* ks = lds + wave * 16384; unsigned char* vs = ks + 8192;
    const int troff = (8 * hh + ((lane & 15) >> 2)) * 64 + (16 * ((lane >> 4) & 1) + 4 * (lane & 3)) * 2;
    for (int unit = bid; unit < 384; unit += G) {
        int db, run, bh;
        if (G == 256) { const int x = bid & 7, j = (unit >> 8) * 32 + (bid >> 3), grp = x * 12 + (j >> 2), bhp = grp >> 4; db = j & 1; run = grp & 15; bh = (bhp / 3) * 6 + 2 * (bhp % 3) + ((j >> 1) & 1); }
        else { db = unit & 1; run = (unit >> 1) & 15; bh = unit >> 5; }
        const int b = bh / 6, h = bh % 6, n = run * 8 + wave;
        const float g128 = exp2f(128.0f * gamma_log2(h));
        const bf16* u2 = (const bf16*)(p.ws + WS_U2); const bf16* ukb = u2 + u2off(b * S + n * 128, C_RK / 64 + (h >> 1)) + (h & 1) * 32; const bf16* uvb = u2 + u2off(b * S + n * 128, C_RV / 64 + h) + db * 32;
        u32x4 kr[8], vr[8];
#pragma unroll
        for (int it = 0; it < 8; ++it) { const int c = lane + 64 * it, row = c >> 2, ch = c & 3; kr[it] = *(const u32x4*)(ukb + row * 64 + ch * 8); vr[it] = *(const u32x4*)(uvb + row * 64 + ch * 8); }
#pragma unroll
        for (int it = 0; it < 8; ++it) { const int c = lane + 64 * it; *(u32x4*)(ks + c * 16) = kr[it]; *(u32x4*)(vs + c * 16) = vr[it]; }
        f32x16 dW;
#pragma unroll
        for (int i = 0; i < 16; ++i) dW[i] = 0.f;
#pragma unroll
        for (int s = 0; s < 8; ++s) { const bf16x8_t af = tr2((const LAS unsigned char*)ks + troff + s * 1024, 256), bfv = tr2((const LAS unsigned char*)vs + troff + s * 1024, 256);
            dW = __builtin_amdgcn_mfma_f32_32x32x16_bf16(af, bfv, dW, 0, 0, 0); }
        float* xw = (float*)ks;
#pragma unroll
        for (int i = 0; i < 16; ++i) xw[i * 64 + lane] = dW[i];
        __syncthreads();
        f32x16 X;
#pragma unroll
        for (int i = 0; i < 16; ++i) X[i] = 0.f;
        float cf = g128;
        for (int j = wave - 1; j >= 0; --j) { const float* xr = (const float*)(lds + j * 16384);
#pragma unroll
            for (int i = 0; i < 16; ++i) X[i] += cf * xr[i * 64 + lane];
            cf *= g128; }
        { float* Pp = Pb + ((size_t)(bh * 128 + n) * 64 + db * 32 + r32) * 32 + 4 * hh;
#pragma unroll
          for (int g = 0; g < 4; ++g) *(f32x4*)(Pp + 8 * g) = (f32x4){X[4 * g], X[4 * g + 1], X[4 * g + 2], X[4 * g + 3]}; }
        if (wave == 7) {
            float* Xp = Xb + ((size_t)(bh * 16 + run) * 64 + db * 32 + r32) * 32 + 4 * hh;
#pragma unroll
            for (int g = 0; g < 4; ++g) *(f32x4*)(Xp + 8 * g) = (f32x4){g128 * (X[4 * g] + dW[4 * g]), g128 * (X[4 * g + 1] + dW[4 * g + 1]), g128 * (X[4 * g + 2] + dW[4 * g + 2]), g128 * (X[4 * g + 3] + dW[4 * g + 3])}; }
        __syncthreads();
    }
    __syncthreads();
}
constexpr int R2_WST = 0, R2_WAVE = 8192, R2_WSTRIDE = 16384;
__device__ __forceinline__ void ph_retII(const P& p, int layer, unsigned char* lds, int bid, int G) {
    const int tid = tid_opaque(), lane = tid & 63, wave = __builtin_amdgcn_readfirstlane(tid >> 6), r32 = lane & 31, hh = lane >> 5;
    const bf16* u = (const bf16*)(p.ws + WS_U); bf16* mix = (bf16*)(p.ws + WS_MIX); const float* Pb = (const float*)(p.ws + WS_KV); const float* Xb = (const float*)(p.ws + WS_ST);
    const float* retg = p.in[6] + layer * 384;
    float* wst = (float*)(lds + R2_WST);
    unsigned char* vs = lds + R2_WAVE + wave * R2_WSTRIDE;
    const int vrow = lane >> 3, vch = lane & 7, vwoff = vrow * 128 + ((vch ^ (((vrow >> 1) & 1) << 2)) * 16);
    const int tq = (lane & 15) >> 2, tp = lane & 3, tsw = (tq >> 1) & 1;
    const int vroff = (4 * hh + tq) * 128 + (2 * ((lane >> 4) & 1) + (tp >> 1)) * 16 + (tp & 1) * 8;
    const int erow = lane >> 1, eh16 = lane & 1;
    for (int bu = bid; bu < 192; bu += G) {
        int bh, run;
        if (G == 256) { const int x = bid & 7, slot = bid >> 3, grp = x * 12 + (slot >> 1), bhp = grp >> 4; run = grp & 15; bh = (bhp / 3) * 6 + 2 * (bhp % 3) + (slot & 1); }
        else { bh = bu >> 4; run = bu & 15; }
        const int b = bh / 6, h = bh % 6, n = run * 8 + wave; const size_t row0 = (size_t)b * S + n * 128; const float l2g = gamma_log2(h);
        const bf16* u2 = (const bf16*)(p.ws + WS_U2); const int gr0 = (int)row0;
        const bf16* uv = u2 + u2off(gr0, C_RV / 64 + h); const bf16* uk = u2 + u2off(gr0, C_RK / 64 + (h >> 1)) + (h & 1) * 32 + 8 * hh; const bf16* uq = u2 + u2off(gr0, C_RQ / 64 + (h >> 1)) + (h & 1) * 32 + 8 * hh;
        const bf16* ug = u2 + u2off(gr0, C_RG / 64 + h);
        u32x4 vr[16];
#pragma unroll
        for (int it = 0; it < 16; ++it) { const int c = lane + 64 * it; vr[it] = *(const u32x4*)(uv + (c >> 3) * 64 + (c & 7) * 8); }
        bf16x8_t qn[2], kf[4][2];
#pragma unroll
        for (int q = 0; q < 4; ++q) { const bf16* rp = uk + (32 * q + r32) * 64; kf[q][0] = *(const bf16x8_t*)rp; kf[q][1] = *(const bf16x8_t*)(rp + 16); }
        { const bf16* rp = uq + r32 * 64; qn[0] = *(const bf16x8_t*)rp; qn[1] = *(const bf16x8_t*)(rp + 16); }
        f32x4 pr[2][2][2];
        { const float* Pp = Pb + ((size_t)(bh * 128 + n) * 64 + r32) * 32 + 8 * hh;
#pragma unroll
          for (int db = 0; db < 2; ++db)
#pragma unroll
              for (int s = 0; s < 2; ++s) { pr[db][s][0] = *(const f32x4*)(Pp + db * 1024 + 16 * s); pr[db][s][1] = *(const f32x4*)(Pp + db * 1024 + 16 * s + 4); } }
        { const int dim = 8 * wave + (lane >> 3), dk4 = (lane & 7) * 4; f32x4 xr[15];
#pragma unroll
          for (int j = 0; j < 15; ++j) { const int m = max(run - 1 - j, 0); xr[j] = *(const f32x4*)(Xb + ((size_t)(bh * 16 + m) * 64 + dim) * 32 + dk4); }
          f32x4 acc = {0.f, 0.f, 0.f, 0.f}; float cf = 1.0f; const float c1024 = exp2f(1024.0f * l2g);
#pragma unroll
          for (int j = 0; j < 15; ++j) { const float cc = j < run ? cf : 0.0f; acc += cc * xr[j]; cf *= c1024; }
          *(f32x4*)(wst + dim * 32 + dk4) = acc; }
        __syncthreads();
        bf16x8_t wf[2][2];
        { const float g128t = exp2f(128.0f * (float)wave * l2g);
#pragma unroll
          for (int db = 0; db < 2; ++db)
#pragma unroll
              for (int s = 0; s < 2; ++s) { const float* wp = wst + (32 * db + r32) * 32 + 16 * s + 8 * hh; const f32x4 a = pr[db][s][0] + g128t * *(const f32x4*)wp, c4 = pr[db][s][1] + g128t * *(const f32x4*)(wp + 4);
                  u32x4 pk; pk.x = cvtpk(a.x, a.y); pk.y = cvtpk(a.z, a.w); pk.z = cvtpk(c4.x, c4.y); pk.w = cvtpk(c4.z, c4.w); wf[db][s] = __builtin_bit_cast(bf16x8_t, pk); } }
#pragma unroll
        for (int it = 0; it < 12; ++it) *(u32x4*)(vs + (it >> 2) * 4096 + vwoff + (it & 3) * 1024) = vr[it];
#pragma unroll 1
        for (int qt = 0; qt < 4; ++qt) {
            bf16x8_t qc[2]; qc[0] = qn[0]; qc[1] = qn[1];
            { const bf16* rp = uq + (32 * min(qt + 1, 3) + r32) * 64; qn[0] = *(const bf16x8_t*)rp; qn[1] = *(const bf16x8_t*)(rp + 16); }
            const bf16* gp = ug + (32 * qt + erow) * 64 + 16 * eh16; u32x4 gv[4];
            gv[0] = *(const u32x4*)gp; gv[1] = *(const u32x4*)(gp + 8); gv[2] = *(const u32x4*)(gp + 32); gv[3] = *(const u32x4*)(gp + 40);
            if (qt == 3) {
#pragma unroll
                for (int it = 0; it < 4; ++it) *(u32x4*)(vs + 3 * 4096 + vwoff + it * 1024) = vr[12 + it]; }
            f32x16 o0, o1;
#pragma unroll
            for (int i = 0; i < 16; ++i) { o0[i] = 0.f; o1[i] = 0.f; }
            o0 = __builtin_amdgcn_mfma_f32_32x32x16_bf16(qc[0], wf[0][0], o0, 0, 0, 0); o0 = __builtin_amdgcn_mfma_f32_32x32x16_bf16(qc[1], wf[0][1], o0, 0, 0, 0);
            o1 = __builtin_amdgcn_mfma_f32_32x32x16_bf16(qc[0], wf[1][0], o1, 0, 0, 0); o1 = __builtin_amdgcn_mfma_f32_32x32x16_bf16(qc[1], wf[1][1], o1, 0, 0, 0);
#pragma unroll
            for (int kt = 0; kt < 4; ++kt) if (kt <= qt) {
                f32x16 s;
#pragma unroll
                for (int i = 0; i < 16; ++i) s[i] = 0.f;
                s = __builtin_amdgcn_mfma_f32_32x32x16_bf16(kf[kt][0], qc[0], s, 0, 0, 0); s = __builtin_amdgcn_mfma_f32_32x32x16_bf16(kf[kt][1], qc[1], s, 0, 0, 0);
                if (kt == qt) {
#pragma unroll
                    for (int i = 0; i < 16; ++i) if ((i & 3) + 8 * (i >> 2) + 4 * hh > r32) s[i] = 0.f; }
                bf16x8_t pf[2];
#pragma unroll
                for (int sx = 0; sx < 2; ++sx) { u32x4 w4; w4.x = cvtpk(s[8 * sx + 0], s[8 * sx + 1]); w4.y = cvtpk(s[8 * sx + 2], s[8 * sx + 3]); w4.z = cvtpk(s[8 * sx + 4], s[8 * sx + 5]); w4.w = cvtpk(s[8 * sx + 6], s[8 * sx + 7]); pf[sx] = __builtin_bit_cast(bf16x8_t, w4); }
#pragma unroll
                for (int sx = 0; sx < 2; ++sx)
#pragma unroll
                    for (int db = 0; db < 2; ++db) { const bf16x8_t vf = tr2((const LAS unsigned char*)vs + kt * 4096 + vroff + sx * 2048 + ((db ^ tsw) * 64), 1024);
                        if (db == 0) o0 = __builtin_amdgcn_mfma_f32_32x32x16_bf16(pf[sx], vf, o0, 0, 0, 0); else o1 = __builtin_amdgcn_mfma_f32_32x32x16_bf16(pf[sx], vf, o1, 0, 0, 0); }
            }
            float* osc = (float*)(vs + (qt == 3 ? 0 : 3 * 4096));
            f32x4 ov[2][4]; float ss = 0.f;
#pragma unroll
            for (int db = 0; db < 2; ++db) {
#pragma unroll
                for (int i = 0; i < 16; ++i) { const int qi = (i & 3) + 8 * (i >> 2) + 4 * hh; osc[qi * 32 + r32] = db == 0 ? o0[i] : o1[i]; }
#pragma unroll
                for (int k = 0; k < 4; ++k) { ov[db][k] = *(const f32x4*)(osc + erow * 32 + 16 * eh16 + 4 * k); ss += (ov[db][k].x * ov[db][k].x + ov[db][k].y * ov[db][k].y) + (ov[db][k].z * ov[db][k].z + ov[db][k].w * ov[db][k].w); } }
            ss += __shfl_xor(ss, 1);
            const float rs = __builtin_amdgcn_rsqf(ss * (1.0f / 64.0f) + EPS);
            bf16* mp = mix + (row0 + 32 * qt + erow) * D + MX_RET + h * 64 + 16 * eh16; const float* rgp = retg + h * 64 + 16 * eh16;
#pragma unroll
            for (int k = 0; k < 4; ++k) { const int db = k >> 1, c8 = 8 * (k & 1); float g[8], o[8]; unpack8(gv[k], g); const f32x4 ra = *(const f32x4*)(rgp + 32 * db + c8), rb = *(const f32x4*)(rgp + 32 * db + c8 + 4);
                const f32x4 a = ov[db][2 * (k & 1)] * rs * ra, c4 = ov[db][2 * (k & 1) + 1] * rs * rb;
                o[0] = a.x; o[1] = a.y; o[2] = a.z; o[3] = a.w; o[4] = c4.x; o[5] = c4.y; o[6] = c4.z; o[7] = c4.w;
#pragma unroll
                for (int e = 0; e < 8; ++e) o[e] *= g[e] * __builtin_amdgcn_rcpf(1.0f + __expf(-g[e]));
                *(u32x4*)(mp + 32 * db + c8) = pack8(o); }
        }
        __syncthreads();
    }
    __syncthreads();
}
template <int WHICH> __device__ __forceinline__ void ph_gemm(const P& p, int layer, unsigned char* lds, int bid, int G, unsigned* arc = nullptr, const XcdBarrier* xbp = nullptr) {
    unsigned char* wb = p.ws + WS_W + (size_t)layer * W_LAYER; float* ssq = (float*)(p.ws + WS_SSQ); bf16* xb = (bf16*)(p.ws + WS_XB);
    pg8::StaticOrder So;
    LAS float* rtab = (LAS float*)((LAS unsigned char*)lds + (WHICH == 0 ? 139264 : 131072));
    if constexpr (WHICH == 0) { pg8::Gemm g{xb, (const bf16*)(wb + W_IN), M, INW, D, D}; So.init(M, INW, G, bid, (G % 8 == 0) ? 1 : 0, (G == 256) ? arc : nullptr, xbp); rstd_prepass(So, ssq, rtab); EpiInProj E{(bf16*)(p.ws + WS_U), rtab, (const float2*)(p.ws + WS_ROPE), p.in[7] + layer * 64, p.in[8] + layer * 64, 0, (bf16*)(p.ws + WS_U2)};
        pg8::gemm_phase<EpiInProj, pg8::StaticOrder, true, true>((LAS unsigned char*)lds, g, So, E); }
    if constexpr (WHICH == 1) { pg8::Gemm g{(const bf16*)(p.ws + WS_MIX), (const bf16*)(wb + W_OUT), M, D, D, D}; So.init(M, D, G, bid); EpiRes E{nullptr, xb, ssq, nullptr};
        pg8::gemm_phase<EpiRes, pg8::StaticOrder, true, true>((LAS unsigned char*)lds, g, So, E); }
    if constexpr (WHICH == 2) { pg8::Gemm g{xb, (const bf16*)(wb + W_F1), M, FF, D, D}; So.init(M, FF, G, bid); rstd_prepass(So, ssq, rtab); EpiNormBf16<1> E{(bf16*)(p.ws + WS_H), rtab, HP, 0};
        pg8::gemm_phase<EpiNormBf16<1>, pg8::StaticOrder, true, true>((LAS unsigned char*)lds, g, So, E); }
    if constexpr (WHICH == 3) { pg8::Gemm g{(const bf16*)(p.ws + WS_H), (const bf16*)(wb + W_F2), M, D, FF, 64}; So.init(M, D, G, bid); EpiRes E{nullptr, xb, ssq, layer + 1 == DEPTH ? p.out : nullptr};
        pg8::gemm_phase<EpiRes, pg8::StaticOrder, true, true, true>((LAS unsigned char*)lds, g, So, E); }
}


constexpr int CW_BAR = 4096;
constexpr int LDS_BYTES = 147456;
constexpr int LDS_MISC = LDS_BYTES - 256;
#define GRID_SYNC() xcd_barrier(bar)
__global__ void __launch_bounds__(512, 2) k_mega(P p) {
    extern __shared__ __attribute__((aligned(16))) unsigned char lds[];
    cg::grid_group grid = cg::this_grid();
    const int bid = (int)blockIdx.x, G = (int)gridDim.x;
    volatile LAS unsigned* MISC = (volatile LAS unsigned*)((LAS unsigned char*)lds + LDS_MISC);
    if (threadIdx.x < 64) MISC[threadIdx.x] = 0u;
    __syncthreads();
    if (bid == 0) for (int i = threadIdx.x; i < XCD_BAR_WORDS + XB_EV_WORDS * 2 * DEPTH; i += 512) ((unsigned*)(p.ws + WS_CTL))[CW_BAR + i] = 0u;
    ph_wconv(p, lds, bid, G);
    ph_xprep(p, bid, G);
    ph_attn_tables(p, bid, G);
    grid.sync();
    XcdBarrier bar = xcd_barrier_post((unsigned*)(p.ws + WS_CTL) + CW_BAR, MISC + 8);
    for (int layer = 0; layer < DEPTH; ++layer) {
        unsigned* arr = (unsigned*)(p.ws + WS_CTL) + CW_BAR + XCD_BAR_WORDS + XB_EV_WORDS * (2 * layer);
        unsigned* arc = arr + XB_EV_WORDS;
        ph_gemm<0>(p, layer, lds, bid, G, arc, &bar);
#pragma unroll 1
        for (int cm = 0; cm < sgpr_opaque(2); ++cm) {
            if (cm == 0) { if (G == 256 && bid >= 128) split_wait(arc, (unsigned)G, (unsigned*)(p.ws + WS_CTL) + CW_BAR); }
            else { GRID_SYNC(); ph_retI(p, lds, bid, G); split_arrive(bar, arr); }
            ph_conv(p, layer, lds, bid, G, cm == 0 ? 1 : 0);
        }
        ph_attn(p, layer, lds, bid, G);
        split_wait(arr, (unsigned)G, (unsigned*)(p.ws + WS_CTL) + CW_BAR);
        ph_retII(p, layer, lds, bid, G);
        GRID_SYNC();
        ph_gemm<1>(p, layer, lds, bid, G);
        GRID_SYNC();
        ph_gemm<2>(p, layer, lds, bid, G);
        GRID_SYNC();
        ph_gemm<3>(p, layer, lds, bid, G);
        if (layer + 1 < DEPTH) GRID_SYNC();
    }
}
extern "C" void kernel_launch(void* const* d_in, const int* in_sizes, int n_in, void* d_out, int out_size, void* d_ws, size_t ws_size, hipStream_t stream) {
    static int grid = 0;
    if (grid == 0) {
        if (n_in != 14 || in_sizes[0] != M * D || out_size != M * D || ws_size < WS_END) { fprintf(stderr, "kernel_launch: unexpected shapes (n_in %d, in0 %d, out %d, ws %zu)\n", n_in, n_in > 0 ? in_sizes[0] : -1, out_size, ws_size); grid = -1; return; }
        int dev = 0, cus = 0, per_cu = 0;
        if (hipGetDevice(&dev) != hipSuccess || hipDeviceGetAttribute(&cus, hipDeviceAttributeMultiprocessorCount, dev) != hipSuccess) { fprintf(stderr, "kernel_launch: device query failed\n"); grid = -1; return; }
        if (hipFuncSetAttribute((const void*)k_mega, hipFuncAttributeMaxDynamicSharedMemorySize, LDS_BYTES) != hipSuccess) { fprintf(stderr, "kernel_launch: hipFuncSetAttribute failed\n"); grid = -1; return; }
        if (hipOccupancyMaxActiveBlocksPerMultiprocessor(&per_cu, (const void*)k_mega, 512, LDS_BYTES) != hipSuccess || per_cu < 1) { fprintf(stderr, "kernel_launch: occupancy query says %d blocks per CU\n", per_cu); grid = -1; return; }
        grid = cus;
        fprintf(stderr, "kernel_launch: %d CUs, occupancy %d per CU, grid %d\n", cus, per_cu, grid);
    }
    if (grid < 0) return;
    P p{}; for (int i = 0; i < 14; ++i) p.in[i] = (const float*)d_in[i];
    p.out = (float*)d_out; p.ws = (unsigned char*)d_ws;
    void* args[] = {&p};
    const hipError_t e = hipLaunchCooperativeKernel((const void*)k_mega, dim3(grid), dim3(512), args, LDS_BYTES, stream);
    if (e != hipSuccess) fprintf(stderr, "kernel_launch: cooperative launch failed: %s (grid %d)\n", hipGetErrorString(e), grid);
}
```
